# Optimizing an MI355X kernel written in HIP

```python
import jax, jax.numpy as jnp
from jax import lax
import numpy as np

D_MODEL = 2048
BATCH = 8
SEQ = 2048
DEPTH = 2

POOL_WIDTH = D_MODEL // 2
POOL_WINDOWS = (2, 4, 8, 16)
N_POOL_GROUPS = len(POOL_WINDOWS)
POOL_GROUP = POOL_WIDTH // N_POOL_GROUPS
HEAD_DIM = 128
N_Q_HEADS = (D_MODEL - POOL_WIDTH) // HEAD_DIM
N_KV_HEADS = 2
Q_PER_KV = N_Q_HEADS // N_KV_HEADS
ATTN_WIDTH = N_Q_HEADS * HEAD_DIM
KV_WIDTH = N_KV_HEADS * HEAD_DIM
MIX_WIDTH = POOL_WIDTH + ATTN_WIDTH
IN_WIDTH = POOL_WIDTH + ATTN_WIDTH + 2 * KV_WIDTH
WINDOW = 128
BLOCK = 128
ROPE_THETA = 500000.0
ROT_DIM = HEAD_DIM // 4
N_GROUPS = 4
EXPERTS_PER_GROUP = 8
N_EXPERTS = N_GROUPS * EXPERTS_PER_GROUP
TOP_K = 2
D_EXPERT = D_MODEL // 4
EPS = 1e-6

kernel_name = "hymba_pool_swa_hmoe_encoder"


def rms_norm(x, g):
    xf = x.astype(jnp.float32)
    y = xf * lax.rsqrt(jnp.mean(xf * xf, axis=-1, keepdims=True) + EPS)
    return (y * g.astype(jnp.float32)).astype(x.dtype)


def multiscale_pool(u, w_pool, pool_scale):
    B, S, _ = u.shape
    uf = u.astype(jnp.float32)
    cs = jnp.concatenate([jnp.zeros((B, 1, POOL_WIDTH), jnp.float32), jnp.cumsum(uf, axis=1)], axis=1)
    t = jnp.arange(S)
    outs = []
    for gi, w in enumerate(POOL_WINDOWS):
        lo = jnp.clip(t - w // 2, 0, S)
        hi = jnp.clip(t + w // 2, 0, S)
        sl = slice(gi * POOL_GROUP, (gi + 1) * POOL_GROUP)
        c = cs[:, :, sl]
        mean = (c[:, hi] - c[:, lo]) / (hi - lo).astype(jnp.float32)[None, :, None]
        outs.append(mean - uf[:, :, sl])
    y = jnp.stack(outs, axis=2).astype(u.dtype)
    y = jnp.einsum('bsgc,gcd->bsgd', y, w_pool).reshape(B, S, POOL_WIDTH)
    return y * pool_scale


def partial_rope(x, positions):
    inv_freq = ROPE_THETA ** (-(jnp.arange(0, ROT_DIM, 2, dtype=jnp.float32) / ROT_DIM))
    ang = positions.astype(jnp.float32)[..., None] * inv_freq
    cos = jnp.cos(ang)[:, :, None, :]
    sin = jnp.sin(ang)[:, :, None, :]
    xf = x.astype(jnp.float32)
    x1 = xf[..., :ROT_DIM // 2]
    x2 = xf[..., ROT_DIM // 2:ROT_DIM]
    out = jnp.concatenate([x1 * cos - x2 * sin, x2 * cos + x1 * sin, xf[..., ROT_DIM:]], axis=-1)
    return out.astype(x.dtype)


def band_attention(q, k, v, sink):
    B, S, _, _ = q.shape
    nb = S // BLOCK
    qb = q.reshape(B, nb, BLOCK, N_KV_HEADS, Q_PER_KV, HEAD_DIM)
    pad = ((0, 0), (BLOCK, BLOCK), (0, 0), (0, 0))

    def neighbour_blocks(t):
        tb = jnp.pad(t, pad).reshape(B, nb + 2, BLOCK, N_KV_HEADS, HEAD_DIM)
        return jnp.concatenate([tb[:, :-2], tb[:, 1:-1], tb[:, 2:]], axis=2)

    kb = neighbour_blocks(k)
    vb = neighbour_blocks(v)
    s = jnp.einsum('bnqkgd,bnckd->bnkgqc', qb, kb,
                   preferred_element_type=jnp.float32) * (HEAD_DIM ** -0.5)
    qi = jnp.arange(nb)[:, None, None] * BLOCK + jnp.arange(BLOCK)[None, :, None]
    kj = jnp.arange(nb)[:, None, None] * BLOCK - BLOCK + jnp.arange(3 * BLOCK)[None, None, :]
    mask = (jnp.abs(kj - qi) <= WINDOW) & (kj >= 0) & (kj < S)
    s = jnp.where(mask[None, :, None, None], s, -jnp.inf)
    sk = sink.astype(jnp.float32).reshape(1, 1, N_KV_HEADS, Q_PER_KV, 1, 1)
    m = jnp.maximum(jnp.max(s, axis=-1, keepdims=True), sk)
    p = jnp.exp(s - m)
    p = (p / (jnp.sum(p, axis=-1, keepdims=True) + jnp.exp(sk - m))).astype(v.dtype)
    o = jnp.einsum('bnkgqc,bnckd->bnqkgd', p, vb)
    return o.reshape(B, S, ATTN_WIDTH)


def hierarchical_moe(h, w_rg, b_rg, w_re, b_re, w_gate, w_up, w_down):
    B, S, D = h.shape
    t = h.reshape(-1, D)
    T = t.shape[0]
    g_prob = jax.nn.softmax((t @ w_rg).astype(jnp.float32) + b_rg, axis=-1)
    g_w, g_idx = lax.top_k(g_prob, 1)
    e_logits = ((t @ w_re).astype(jnp.float32) + b_re).reshape(T, N_GROUPS, EXPERTS_PER_GROUP)
    sel = jnp.broadcast_to(g_idx[:, :, None], (T, 1, EXPERTS_PER_GROUP))
    e_logits = jnp.take_along_axis(e_logits, sel, axis=1)[:, 0]
    e_w, e_idx = lax.top_k(jax.nn.softmax(e_logits, axis=-1), TOP_K)
    weights = g_w * (e_w / jnp.sum(e_w, axis=-1, keepdims=True))
    expert_id = g_idx * EXPERTS_PER_GROUP + e_idx
    combine = jnp.sum(jax.nn.one_hot(expert_id, N_EXPERTS, dtype=jnp.float32)
                      * weights[..., None], axis=1).astype(h.dtype)
    out = jnp.zeros_like(t)
    for e in range(N_EXPERTS):
        a = jax.nn.silu(t @ w_gate[e]) * (t @ w_up[e])
        out = out + combine[:, e:e + 1] * (a @ w_down[e])
    return out.reshape(B, S, D)


def setup_inputs(seed: int = 0) -> dict:
    key = jax.random.key(seed)
    ks = jax.random.split(key, 20)
    f32 = jnp.float32
    nrm = lambda k, shape, scale: jax.random.normal(k, shape, f32) * scale
    gain = lambda k, shape: 1.0 + 0.02 * jax.random.normal(k, shape, f32)
    x = jax.random.normal(ks[0], (BATCH, SEQ, D_MODEL), f32)
    offsets = jax.random.randint(ks[1], (BATCH, 1), 0, SEQ, dtype=jnp.int32)
    positions = (jnp.arange(SEQ, dtype=jnp.int32)[None, :] + offsets).astype(jnp.int32)
    return {
        "x": x,
        "positions": positions,
        "norm_mix": gain(ks[2], (DEPTH, D_MODEL)),
        "w_in": nrm(ks[3], (DEPTH, D_MODEL, IN_WIDTH), D_MODEL ** -0.5),
        "w_pool": nrm(ks[4], (DEPTH, N_POOL_GROUPS, POOL_GROUP, POOL_GROUP), POOL_GROUP ** -0.5),
        "pool_scale": 1.0 + 0.1 * jax.random.normal(ks[5], (DEPTH, POOL_WIDTH), f32),
        "q_norm": gain(ks[6], (DEPTH, HEAD_DIM)),
        "k_norm": gain(ks[7], (DEPTH, HEAD_DIM)),
        "sink": nrm(ks[8], (DEPTH, N_Q_HEADS), 0.5),
        "branch_gain_pool": gain(ks[9], (DEPTH, POOL_WIDTH)),
        "branch_gain_attn": gain(ks[10], (DEPTH, ATTN_WIDTH)),
        "w_out": nrm(ks[11], (DEPTH, MIX_WIDTH, D_MODEL), (2.0 * MIX_WIDTH) ** -0.5),
        "norm_ffn": gain(ks[12], (DEPTH, D_MODEL)),
        "w_router_group": nrm(ks[13], (DEPTH, D_MODEL, N_GROUPS), D_MODEL ** -0.5),
        "b_router_group": nrm(ks[14], (DEPTH, N_GROUPS), 0.01),
        "w_router_expert": nrm(ks[15], (DEPTH, D_MODEL, N_EXPERTS), D_MODEL ** -0.5),
        "b_router_expert": nrm(ks[16], (DEPTH, N_EXPERTS), 0.01),
        "w_gate": nrm(ks[17], (DEPTH, N_EXPERTS, D_MODEL, D_EXPERT), D_MODEL ** -0.5),
        "w_up": nrm(ks[18], (DEPTH, N_EXPERTS, D_MODEL, D_EXPERT), D_MODEL ** -0.5),
        "w_down": nrm(ks[19], (DEPTH, N_EXPERTS, D_EXPERT, D_MODEL), D_EXPERT ** -0.5),
    }


def reference(x, positions, norm_mix, w_in, w_pool, pool_scale, q_norm, k_norm, sink,
              branch_gain_pool, branch_gain_attn, w_out, norm_ffn, w_router_group,
              b_router_group, w_router_expert, b_router_expert, w_gate, w_up, w_down):
    B, S, _ = x.shape
    splits = [POOL_WIDTH, POOL_WIDTH + ATTN_WIDTH, POOL_WIDTH + ATTN_WIDTH + KV_WIDTH]
    for l in range(DEPTH):
        h = rms_norm(x, norm_mix[l])
        z = h @ w_in[l]
        u, q, k, v = jnp.split(z, splits, axis=-1)
        pool_out = multiscale_pool(u, w_pool[l], pool_scale[l])
        q = q.reshape(B, S, N_Q_HEADS, HEAD_DIM)
        k = k.reshape(B, S, N_KV_HEADS, HEAD_DIM)
        v = v.reshape(B, S, N_KV_HEADS, HEAD_DIM)
        q = partial_rope(rms_norm(q, q_norm[l]), positions)
        k = partial_rope(rms_norm(k, k_norm[l]), positions)
        attn_out = band_attention(q, k, v, sink[l])
        mixed = jnp.concatenate([rms_norm(pool_out, branch_gain_pool[l]),
                                 rms_norm(attn_out, branch_gain_attn[l])], axis=-1)
        x = x + mixed @ w_out[l]
        h = rms_norm(x, norm_ffn[l])
        x = x + hierarchical_moe(h, w_router_group[l], b_router_group[l], w_router_expert[l],
                                 b_router_expert[l], w_gate[l], w_up[l], w_down[l])
    return x
```

```cpp
#include <hip/hip_runtime.h>
#include <cstdio>
#include <cstdint>

#ifndef BAR_DELAY_TICKS
#define BAR_DELAY_TICKS 0ull
#endif
#ifndef START_DELAY_TICKS
#define START_DELAY_TICKS 0ull
#endif
#ifndef MK_ONE_LAUNCH
#define MK_ONE_LAUNCH 1
#endif

constexpr int D = 2048, BATCH = 8, SEQ = 2048, T = BATCH * SEQ, DEPTH = 2;
constexpr int POOLW = 1024, ATTW = 1024, KVW = 256, NIN = 2560, HD = 128, NQH = 8;
constexpr int NEXP = 32, EPG = 8, DEXP = 512;
constexpr float EPS = 1e-6f;
constexpr int NWAVES = 8, NTHREADS = 512;
constexpr int NPH = 1 + 7 * DEPTH;

constexpr size_t MiB = 1u << 20;
constexpr size_t WS_CTL = 0, CTL_ZERO_BYTES = 1 * MiB;
constexpr size_t WS_HB = 2 * MiB;
constexpr size_t WS_Z = WS_HB + 64 * MiB;
constexpr size_t WS_VT = WS_Z + 80 * MiB;
constexpr size_t WS_MIX = WS_VT + 8 * MiB;
constexpr size_t WS_ABUF = WS_MIX + 64 * MiB;
constexpr size_t WS_Y = WS_ABUF + 40 * MiB;
constexpr size_t WS_LIST = WS_Y + 128 * MiB;
constexpr size_t WS_CW = WS_LIST + 2 * MiB;
constexpr size_t WS_WIN = WS_CW + 1 * MiB;
constexpr size_t WS_WOUT = WS_WIN + 20 * MiB;
constexpr size_t WS_WGU = WS_WOUT + 16 * MiB;
constexpr size_t WS_WD = WS_WGU + 256 * MiB;
constexpr size_t WS_WPOOL = WS_WD + 128 * MiB;
constexpr size_t WS_ROPE = WS_WPOOL + 1 * MiB;
constexpr size_t WS_WR = WS_ROPE + 2 * MiB;
constexpr size_t WS_XRB = WS_WR + 1 * MiB;
constexpr size_t WS_X1B = WS_XRB + 64 * MiB;
constexpr size_t WS_RS2 = WS_X1B + 64 * MiB;
constexpr size_t WS_RS1 = WS_RS2 + 1 * MiB;
constexpr size_t WS_END = WS_RS1 + 1 * MiB;
constexpr int CW_TMO = 0, CW_CODE = 1;
constexpr int CW_BAR = 4096;
constexpr int CW_CNT = 131072;

constexpr int RING_BYTES = 131072;
constexpr int LDSCTL_OFF = RING_BYTES, MISC_OFF = LDSCTL_OFF + 320;
constexpr int LDS_BYTES = 147456;
constexpr int CNT_OFF = LDSCTL_OFF + 512, BASE_OFF = LDSCTL_OFF + 640, USTART_OFF = LDSCTL_OFF + 768;

#define GAS __attribute__((address_space(1)))
#define LAS __attribute__((address_space(3)))
typedef unsigned short bf16;
typedef unsigned v4u __attribute__((ext_vector_type(4)));
typedef unsigned v2u __attribute__((ext_vector_type(2)));
typedef float f32x4 __attribute__((ext_vector_type(4)));
typedef float f32x16 __attribute__((ext_vector_type(16)));
typedef short bf16x8 __attribute__((ext_vector_type(8)));
typedef GAS unsigned gu32;
#define RLX_AGENT __ATOMIC_RELAXED, __HIP_MEMORY_SCOPE_AGENT
typedef __amdgpu_buffer_rsrc_t rsrc_t;
__device__ __forceinline__ rsrc_t mk_rsrc(const void* base, size_t bytes) { return __builtin_amdgcn_make_buffer_rsrc((void*)base, 0, (int)bytes, 0x00020000); }
#define ST16(r, off, v) __builtin_amdgcn_raw_buffer_store_b128((v), (r), (int)(off), 0, ST_AUX)
#ifndef ST_AUX
#define ST_AUX 0
#endif
#define ST4(r, off, v)  __builtin_amdgcn_raw_buffer_store_b32((v), (r), (int)(off), 0, ST_AUX)
#define ST2(r, off, v)  __builtin_amdgcn_raw_buffer_store_b16((v), (r), (int)(off), 0, ST_AUX)

__device__ __forceinline__ unsigned f2bf(float f) { unsigned u = __builtin_bit_cast(unsigned, f); return (u + 0x7fffu + ((u >> 16) & 1u)) >> 16; }
__device__ __forceinline__ unsigned pk2(float lo, float hi) { return f2bf(lo) | (f2bf(hi) << 16); }
__device__ __forceinline__ float bflo(unsigned u) { return __builtin_bit_cast(float, u << 16); }
__device__ __forceinline__ float bfhi(unsigned u) { return __builtin_bit_cast(float, u & 0xffff0000u); }
__device__ __forceinline__ float bf2f(bf16 b) { return __builtin_bit_cast(float, (unsigned)b << 16); }
__device__ __forceinline__ float wave_sum(float v) {
#pragma unroll
    for (int o = 1; o < 64; o <<= 1) v += __shfl_xor(v, o);
    return v;
}

#define XB_TMO      128
#define XB_XCNT(j)  (256  + 64 * (j))
#define XB_XSUB(j)  (1280 + 64 * (j))
#define XB_XGEN(j)  (2304 + 64 * (j))
#define XB_TOP      3328
#define XB_TOPGEN   3392
#define XCD_BAR_WORDS 3456
#define XB_SPIN_CAP (1u << 18)

__device__ __forceinline__ unsigned xb_ld(unsigned* p)              { return __hip_atomic_load(p, __ATOMIC_RELAXED, __HIP_MEMORY_SCOPE_AGENT); }
__device__ __forceinline__ unsigned xb_add(unsigned* p, unsigned v) { return __hip_atomic_fetch_add(p, v, __ATOMIC_RELAXED, __HIP_MEMORY_SCOPE_AGENT); }
__device__ __forceinline__ unsigned xb_xcc_id() { return (unsigned)__builtin_amdgcn_s_getreg((3 << 11) | 20) & 0xFu; }
#define XB_SPIN(cond, bar) do { unsigned _sp = 0; while (cond) { __builtin_amdgcn_s_sleep(1); \
    if ((++_sp & 255u) == 0u) { if (xb_ld(&(bar)[XB_TMO])) break; if (_sp > XB_SPIN_CAP) { atomicAdd(&(bar)[XB_TMO], 1u); break; } } } } while (0)

struct XcdBarrier {
    unsigned* bar; unsigned x;
    volatile LAS unsigned* st;
};
__device__ __forceinline__ XcdBarrier xcd_barrier_post(unsigned* bar, volatile LAS unsigned* st) {
    XcdBarrier b; b.bar = bar; b.x = xb_xcc_id(); b.st = st;
    if (threadIdx.x == 0) (void)xb_add(&bar[XB_XCNT(b.x)], 1u);
    return b;
}
__device__ __forceinline__ void xcd_barrier_complete(unsigned* bar, unsigned x, unsigned& nloc, unsigned& nx) {
    const unsigned G = gridDim.x * gridDim.y * gridDim.z;
    unsigned sum, cnt, mine, sp = 0u;
    for (;;) {
        sum = 0u; cnt = 0u; mine = 0u;
#pragma unroll
        for (unsigned j = 0; j < 16; ++j) { const unsigned c = xb_ld(&bar[XB_XCNT(j)]); sum += c; cnt += (c > 0u) ? 1u : 0u; mine = (j == x) ? c : mine; }
        if (sum == G) break;
        __builtin_amdgcn_s_sleep(1);
        if ((++sp & 255u) == 0u) { if (xb_ld(&bar[XB_TMO])) break; if (sp > XB_SPIN_CAP) { atomicAdd(&bar[XB_TMO], 1u); break; } }
    }
    nloc = mine > 0u ? mine : 1u; nx = cnt > 0u ? cnt : 1u;
}
__device__ __forceinline__ void xcd_barrier(const XcdBarrier& b) {
    asm volatile("s_waitcnt vmcnt(0)" ::: "memory");
    __syncthreads();
    int t0_ = threadIdx.x; asm volatile("" : "+v"(t0_));
    if (t0_ == 0) {
        unsigned* bar = b.bar;
        __builtin_amdgcn_s_waitcnt(0);
        unsigned nloc = b.st[0], nx = b.st[1];
        if (nloc == 0u) { xcd_barrier_complete(bar, b.x, nloc, nx); b.st[0] = nloc; b.st[1] = nx; }
        const unsigned old = xb_add(&bar[XB_XSUB(b.x)], 1u);
        const unsigned gen = old / nloc;
        if (old + 1u == (gen + 1u) * nloc) {
            __builtin_amdgcn_fence(__ATOMIC_RELEASE, "agent");
            asm volatile("s_waitcnt vmcnt(0)" ::: "memory");
            const unsigned og = xb_add(&bar[XB_TOP], 1u);
            const unsigned tg = og / nx;
            if (og + 1u == (tg + 1u) * nx) xb_add(&bar[XB_TOPGEN], 1u);
            else XB_SPIN(xb_ld(&bar[XB_TOPGEN]) == tg, bar);
            __builtin_amdgcn_fence(__ATOMIC_ACQUIRE, "agent");
            xb_add(&bar[XB_XGEN(b.x)], 1u);
            asm volatile("s_waitcnt vmcnt(0)" ::: "memory");
        } else {
            XB_SPIN(xb_ld(&bar[XB_XGEN(b.x)]) == gen, bar);
            __builtin_amdgcn_fence(__ATOMIC_ACQUIRE, "agent");
            asm volatile("s_waitcnt vmcnt(0)" ::: "memory");
        }
    }
#if BAR_DELAY_TICKS
    if (threadIdx.x == 0) { const unsigned long long t0_ = __builtin_amdgcn_s_memrealtime(); while (__builtin_amdgcn_s_memrealtime() - t0_ < BAR_DELAY_TICKS) __builtin_amdgcn_s_sleep(2); }
#endif
    __syncthreads();
}
struct Args { const void* in[20]; float* out; unsigned char* ws; int ph_lo, ph_hi, li, pad; };

struct Frame {
    LAS unsigned char* lds;
    gu32* ctl;
    int tid, lane, wave, G, bid;
    const float* x; const int* pos;
    const float *norm_mix, *w_in, *w_pool, *pool_scale, *q_norm, *k_norm, *sink, *g_pool, *g_attn, *w_out, *norm_ffn, *w_rg, *b_rg, *w_re, *b_re, *w_gate, *w_up, *w_down;
    float* out;
    bf16 *HB, *Z, *VT, *MIX, *ABUF, *Y;
    int* LIST; float* CW;
    bf16 *WIN_T, *WOUT_T, *WGU_T, *WD_T, *WP_T, *WR_T, *XRB, *X1B; float* ROPE; float* RS2; float* RS1;
};

#define MFMA32(a, b, c) __builtin_amdgcn_mfma_f32_32x32x16_bf16((a), (b), (c), 0, 0, 0)
__device__ __forceinline__ int crow(int reg, int h) { return (reg & 3) + 8 * (reg >> 2) + 4 * h; }

__device__ __forceinline__ void unpack8(const v4u p, float (&x)[8]) { x[0] = bflo(p.x); x[1] = bfhi(p.x); x[2] = bflo(p.y); x[3] = bfhi(p.y); x[4] = bflo(p.z); x[5] = bfhi(p.z); x[6] = bflo(p.w); x[7] = bfhi(p.w); }
__device__ __forceinline__ v4u pack8(const float (&x)[8]) { v4u w; w.x = pk2(x[0], x[1]); w.y = pk2(x[2], x[3]); w.z = pk2(x[4], x[5]); w.w = pk2(x[6], x[7]); return w; }
__device__ __forceinline__ void norm_gains(const float* g, int lane, f32x4 (&gg)[8]) {
    const f32x4* gr = (const f32x4*)g;
#pragma unroll
    for (int j = 0; j < 4; ++j) { gg[2 * j] = gr[(j * 64 + lane) * 2]; gg[2 * j + 1] = gr[(j * 64 + lane) * 2 + 1]; }
}
__device__ __forceinline__ float norm_store(const float (&xv)[4][8], const f32x4 (&gg)[8], rsrc_t ob, size_t obyte, int lane) {
    float s = 0.f;
#pragma unroll
    for (int j = 0; j < 4; ++j)
#pragma unroll
        for (int e = 0; e < 8; ++e) s += xv[j][e] * xv[j][e];
    const float rstd = 1.0f / sqrtf(wave_sum(s) * (1.0f / D) + EPS);
#pragma unroll
    for (int j = 0; j < 4; ++j) { const f32x4 g0 = gg[2 * j], g1 = gg[2 * j + 1];
        const float y[8] = {xv[j][0] * rstd * g0.x, xv[j][1] * rstd * g0.y, xv[j][2] * rstd * g0.z, xv[j][3] * rstd * g0.w, xv[j][4] * rstd * g1.x, xv[j][5] * rstd * g1.y, xv[j][6] * rstd * g1.z, xv[j][7] * rstd * g1.w};
        ST16(ob, obyte + (size_t)(j * 64 + lane) * 16, pack8(y)); }
    return rstd;
}

__device__ __forceinline__ float row_rstd(const float (&xv)[4][8]) {
    float s = 0.f;
#pragma unroll
    for (int j = 0; j < 4; ++j)
#pragma unroll
        for (int e = 0; e < 8; ++e) s += xv[j][e] * xv[j][e];
    return 1.0f / sqrtf(wave_sum(s) * (1.0f / D) + EPS);
}
__device__ __forceinline__ void p_prologue_rows(Frame& F) {
    const int gw = F.bid * NWAVES + F.wave, NGW = F.G * NWAVES, lane = F.lane;
    const rsrc_t hb = mk_rsrc(F.HB, (size_t)T * D * 2), xb = mk_rsrc(F.XRB, (size_t)T * D * 2);
    f32x4 cu[8], nx[8];
    if (gw < T) { const f32x4* xr = (const f32x4*)(F.x + (size_t)gw * D);
#pragma unroll
        for (int j = 0; j < 4; ++j) { cu[2 * j] = xr[(j * 64 + lane) * 2]; cu[2 * j + 1] = xr[(j * 64 + lane) * 2 + 1]; } }
    for (int m = gw; m < T; m += NGW) {
        if (m + NGW < T) { const f32x4* xr = (const f32x4*)(F.x + (size_t)(m + NGW) * D);
#pragma unroll
            for (int j = 0; j < 4; ++j) { nx[2 * j] = xr[(j * 64 + lane) * 2]; nx[2 * j + 1] = xr[(j * 64 + lane) * 2 + 1]; } }
        __builtin_amdgcn_sched_barrier(0);
        float xv[4][8];
#pragma unroll
        for (int j = 0; j < 4; ++j) { const f32x4 a = cu[2 * j], c = cu[2 * j + 1]; xv[j][0] = a.x; xv[j][1] = a.y; xv[j][2] = a.z; xv[j][3] = a.w; xv[j][4] = c.x; xv[j][5] = c.y; xv[j][6] = c.z; xv[j][7] = c.w; }
#pragma unroll
        for (int j = 0; j < 4; ++j) ST16(xb, (size_t)m * D * 2 + (size_t)(j * 64 + lane) * 16, pack8(xv[j]));
        { const float rs_ = row_rstd(xv); if (lane == 0) F.RS1[m] = rs_; }
#pragma unroll
        for (int j = 0; j < 8; ++j) cu[j] = nx[j];
    }
}

struct RtOut { int* LIST; float* CW; unsigned* cnt; int* EID; };
__device__ __forceinline__ void load_counts(Frame& F, int l, int nN) {
    LAS int* cnt_s = (LAS int*)(F.lds + CNT_OFF); LAS int* base_s = (LAS int*)(F.lds + BASE_OFF); LAS int* ustart = (LAS int*)(F.lds + USTART_OFF);
    __syncthreads();
    if (F.tid < 32) cnt_s[F.tid] = (int)__hip_atomic_load((unsigned*)(F.ctl + CW_CNT) + (l * 32 + F.tid) * 64, RLX_AGENT);
    __syncthreads();
    if (F.tid == 0) { int b = 0, us = 0; for (int e = 0; e < 32; ++e) { base_s[e] = b; ustart[e] = us; b += (cnt_s[e] + 255) & ~255; us += ((cnt_s[e] + 255) >> 8) * nN; } ustart[32] = us; }
    __syncthreads();
}

__device__ __forceinline__ void p_combine(Frame& F, int l) {
    const int gw = F.bid * NWAVES + F.wave, NGW = F.G * NWAVES; const int lane = F.lane;
    const rsrc_t ob = mk_rsrc(F.out, (size_t)T * D * 4), xb = mk_rsrc(F.XRB, (size_t)T * D * 2), hb = mk_rsrc(F.HB, (size_t)T * D * 2);
    v4u a[4], p[4], q[4], an[4], pn[4], qn[4];
    if (gw < T) { const v4u* x1 = (const v4u*)(F.X1B + (size_t)gw * D); const v4u* y0 = (const v4u*)(F.Y + (size_t)(2 * gw) * D); const v4u* y1 = (const v4u*)(F.Y + (size_t)(2 * gw + 1) * D);
#pragma unroll
        for (int j = 0; j < 4; ++j) { const int c = j * 64 + lane; a[j] = x1[c]; p[j] = y0[c]; q[j] = y1[c]; } }
    for (int t = gw; t < T; t += NGW) {
        if (t + NGW < T) { const int tn = t + NGW; const v4u* x1 = (const v4u*)(F.X1B + (size_t)tn * D); const v4u* y0 = (const v4u*)(F.Y + (size_t)(2 * tn) * D); const v4u* y1 = (const v4u*)(F.Y + (size_t)(2 * tn + 1) * D);
#pragma unroll
            for (int j = 0; j < 4; ++j) { const int c = j * 64 + lane; an[j] = x1[c]; pn[j] = y0[c]; qn[j] = y1[c]; } }
        __builtin_amdgcn_sched_barrier(0);
        float xv[4][8];
#pragma unroll
        for (int j = 0; j < 4; ++j) { float u[8], v[8], w[8]; unpack8(a[j], u); unpack8(p[j], v); unpack8(q[j], w);
#pragma unroll
            for (int e = 0; e < 8; ++e) xv[j][e] = u[e] + v[e] + w[e]; }
        if (l + 1 < DEPTH) {
#pragma unroll
            for (int j = 0; j < 4; ++j) ST16(xb, (size_t)t * D * 2 + (size_t)(j * 64 + lane) * 16, pack8(xv[j]));
            { const float rs_ = row_rstd(xv); if (lane == 0) F.RS1[t] = rs_; }
        } else {
#pragma unroll
            for (int j = 0; j < 4; ++j) { const int c = j * 64 + lane; const f32x4 o0 = {xv[j][0], xv[j][1], xv[j][2], xv[j][3]}, o1 = {xv[j][4], xv[j][5], xv[j][6], xv[j][7]};
                ST16(ob, ((size_t)t * D + 8 * c) * 4, __builtin_bit_cast(v4u, o0)); ST16(ob, ((size_t)t * D + 8 * c + 4) * 4, __builtin_bit_cast(v4u, o1)); }
        }
#pragma unroll
        for (int j = 0; j < 4; ++j) { a[j] = an[j]; p[j] = pn[j]; q[j] = qn[j]; }
    }
}

namespace pg8 {
typedef unsigned u32x4 __attribute__((ext_vector_type(4)));
constexpr int BM = 256, BK = 64, HALF = 128, HTB = HALF * BK * 2, STAGE_BYTES = 8 * HTB, NXCD = 8, WGM = 8;
__host__ __device__ __forceinline__ int lds_byte(int r, int c) { const int st = (r >> 4) * 2 + (c >> 5), rr = r & 15, cc = c & 31, ob = rr * 64 + cc * 2; return st * 1024 + (ob ^ (((ob >> 9) & 1) << 5)); }
__host__ __device__ __forceinline__ void stage_rc(int b, int& R, int& C) { const int st = b / 1024, sb = b % 1024, swz = sb ^ (((sb >> 9) & 1) << 5); R = (st >> 1) * 16 + swz / 64; C = (st & 1) * 32 + (swz % 64) / 2; }
__host__ __device__ __forceinline__ int perm32(int rho) { const int n = rho >> 4, i = rho & 15; return 8 * (i >> 2) + 4 * n + (i & 3); }

struct Unit { const char* a; const char* b; int pm, pn, e, rows, rbase, half; };

__device__ __forceinline__ int xcd_remap(int L, int nwg) { const int q = nwg / NXCD, r = nwg % NXCD, xcd = L % NXCD, off = L / NXCD; return (xcd < r ? xcd * (q + 1) : r * (q + 1) + (xcd - r) * q) + off; }

struct DenseOrder {
    int nM, nN, nwg, G, c, K; const char* A; const char* Bt;
    __device__ __forceinline__ void init(const bf16* A_, const bf16* Bt_, int M, int N, int K_, int G_, int c_) { A = (const char*)A_; Bt = (const char*)Bt_; nM = M / BM; nN = N / BM; nwg = nM * nN; G = G_; c = c_; K = K_; }
    __device__ __forceinline__ bool next(int i, Unit& u) const {
        int L = i * G + c, half = -1;
        if (G == 256 && nwg == 640 && i == 2) { L = 512 + (c & 127); half = c >> 7; }
        if (L >= nwg) return false;
        u.half = half;
        const int wgid = xcd_remap(L, nwg);
        const int nig = WGM * nN, gid = wgid / nig, fm = gid * WGM, gsz = (nM - fm) < WGM ? (nM - fm) : WGM;
        u.pm = fm + ((wgid % nig) % gsz); u.pn = (wgid % nig) / gsz; u.e = 0; u.rows = BM; u.rbase = u.pm * BM;
        u.a = A + (size_t)u.pm * BM * K * 2; u.b = Bt + (size_t)u.pn * BM * K * 2; return true;
    }
    __device__ __forceinline__ unsigned gather_off(const Unit&, int) const { return 0u; }
};
struct MoeOrder {
    const LAS int* cnt_s; const LAS int* base_s; const LAS int* ustart; int nN, G, c, K, total, gather; const char* A; const char* Bt; size_t b_estride; const int* LIST;
    __device__ __forceinline__ bool next(int i, Unit& u) const {
        const int L = i * G + c; if (L >= total) return false;
        const int wgid = xcd_remap(L, total);
        const int lane_ = (int)(threadIdx.x & 31u);
        const unsigned long long msk = __ballot(wgid < ustart[lane_ + 1]);
        int e = __builtin_ctzll(msk | (1ull << 31)) & 31;
        e = __builtin_amdgcn_readfirstlane(e);
        const int loc = wgid - __builtin_amdgcn_readfirstlane(ustart[e]), cnt = __builtin_amdgcn_readfirstlane(cnt_s[e]), mtl = (cnt + 255) >> 8, mt = loc % mtl, pn = loc / mtl;
        u.half = -1; u.e = e; u.pm = mt; u.pn = pn; u.rows = (cnt - mt * BM) < BM ? (cnt - mt * BM) : BM; u.rbase = __builtin_amdgcn_readfirstlane(base_s[e]) + mt * BM;
        u.b = Bt + (size_t)e * b_estride + (size_t)pn * BM * K * 2;
        u.a = gather ? A : A + (size_t)u.rbase * K * 2;
        return true;
    }
    __device__ __forceinline__ unsigned gather_off(const Unit& u, int r) const { const int rr = r < u.rows ? r : u.rows - 1; return (unsigned)(LIST[(size_t)u.e * T + u.pm * BM + rr] >> 1) * (unsigned)(K * 2); }
};

__device__ __forceinline__ unsigned cvt_pk_bf16(float lo, float hi) { unsigned r; asm volatile("v_cvt_pk_bf16_f32 %0, %1, %2" : "=v"(r) : "v"(lo), "v"(hi)); return r; }

struct EpiZ {
    static constexpr bool PERM = true;
    rsrc_t Z; rsrc_t VT; int l;
    __device__ __forceinline__ void kprep(const f32x4 (&acc)[2][2][4][2], const Unit& u, int wr_, int wc_, int fr_, int fq_) const {
        int fr = fr_, fq = fq_; asm volatile("" : "+v"(fr), "+v"(fq));
        const int wr = wr_, wc = wc_;
        const int row0 = u.rbase + wr * 64 + fr, col0 = u.pn * BM + wc * 32 + 8 * fq;
            const __attribute__((address_space(4))) Args* ka_ = (const __attribute__((address_space(4))) Args*)__builtin_amdgcn_kernarg_segment_ptr();
            const float* kg = (const float*)ka_->in[7] + l * HD; const float* rope = (const float*)(ka_->ws + WS_ROPE); LAS float* red = (LAS float*)(unsigned)(LDSCTL_OFF + 2048);
            const float* rs1 = (const float*)(ka_->ws + WS_RS1);
            float rsv[2][4];
#pragma unroll
            for (int ai = 0; ai < 2; ++ai)
#pragma unroll
                for (int m = 0; m < 4; ++m) rsv[ai][m] = rs1[row0 + ai * HALF + m * 16];
#pragma unroll
            for (int ai = 0; ai < 2; ++ai)
#pragma unroll
                for (int m = 0; m < 4; ++m)
#pragma unroll
                    for (int bj = 0; bj < 2; ++bj) { if (u.half >= 0 && ai != u.half) continue; const f32x4 v0 = acc[ai][bj][m][0], v1 = acc[ai][bj][m][1];
                        float q = v0[0] * v0[0] + v0[1] * v0[1] + v0[2] * v0[2] + v0[3] * v0[3] + v1[0] * v1[0] + v1[1] * v1[1] + v1[2] * v1[2] + v1[3] * v1[3];
                        q *= rsv[ai][m] * rsv[ai][m];
                        q += __shfl_xor(q, 16); q += __shfl_xor(q, 32);
                        if (fq == 0) red[(bj * 256 + ai * HALF + wr * 64 + m * 16 + fr) * 4 + wc] = q; }
            asm volatile("s_waitcnt lgkmcnt(0)" ::: "memory"); __builtin_amdgcn_s_barrier(); asm volatile("" ::: "memory");
            const f32x4 g0 = *(const f32x4*)(kg + wc * 32 + 8 * fq), g1 = *(const f32x4*)(kg + wc * 32 + 8 * fq + 4);
#pragma unroll
            for (int ai = 0; ai < 2; ++ai)
#pragma unroll
                for (int m = 0; m < 4; ++m) { if (u.half >= 0 && ai != u.half) continue; const int r = row0 + ai * HALF + m * 16; const size_t ro = ((size_t)r * NIN + col0) * 2;
                    f32x4 c0 = {1.f, 1.f, 1.f, 1.f}, c1 = c0, s0 = {0.f, 0.f, 0.f, 0.f}, s1 = s0;
                    if (wc == 0) { const float* rp = rope + (size_t)r * 32 + 8 * (fq & 1); c0 = *(const f32x4*)rp; c1 = *(const f32x4*)(rp + 4); s0 = *(const f32x4*)(rp + 16); s1 = *(const f32x4*)(rp + 20); }
#pragma unroll
                    for (int bj = 0; bj < 2; ++bj) {
                        const f32x4 t4 = *(const LAS f32x4*)(red + (bj * 256 + ai * HALF + wr * 64 + m * 16 + fr) * 4);
                        const float rstd = 1.0f / sqrtf(((t4[0] + t4[1]) + (t4[2] + t4[3])) * (1.0f / 128.0f) + 1e-6f);
                        f32x4 v0 = acc[ai][bj][m][0] * (rstd * rsv[ai][m]) * g0, v1 = acc[ai][bj][m][1] * (rstd * rsv[ai][m]) * g1;
                        if (wc == 0) {
#pragma unroll
                            for (int e = 0; e < 4; ++e) { const float p0 = __shfl_xor(v0[e], 32), p1 = __shfl_xor(v1[e], 32);
                                v0[e] = (fq < 2) ? v0[e] * c0[e] - p0 * s0[e] : v0[e] * c0[e] + p0 * s0[e];
                                v1[e] = (fq < 2) ? v1[e] * c1[e] - p1 * s1[e] : v1[e] * c1[e] + p1 * s1[e]; } }
                        u32x4 w; w.x = cvt_pk_bf16(v0[0], v0[1]); w.y = cvt_pk_bf16(v0[2], v0[3]); w.z = cvt_pk_bf16(v1[0], v1[1]); w.w = cvt_pk_bf16(v1[2], v1[3]);
                        ST16(Z, ro + bj * HALF * 2, w); }
                    __builtin_amdgcn_sched_barrier(0); }
            asm volatile("s_waitcnt lgkmcnt(0)" ::: "memory"); __builtin_amdgcn_s_barrier(); asm volatile("" ::: "memory");
    }
    __device__ __forceinline__ void operator()(const f32x4 (&acc)[2][2][4][2], const Unit& u, int wr, int wc, int fr, int fq) const {
        if (u.pn == 8) { kprep(acc, u, wr, wc, fr, fq); return; }
        const int row0 = u.rbase + wr * 64 + fr, col0 = u.pn * BM + wc * 32 + 8 * fq;
        const float* rs1 = (const float*)(((const __attribute__((address_space(4))) Args*)__builtin_amdgcn_kernarg_segment_ptr())->ws + WS_RS1);
        float rsv[2][4];
#pragma unroll
        for (int ai = 0; ai < 2; ++ai)
#pragma unroll
            for (int m = 0; m < 4; ++m) rsv[ai][m] = rs1[row0 + ai * HALF + m * 16];
        __builtin_amdgcn_sched_barrier(0);
#pragma unroll
        for (int ai = 0; ai < 2; ++ai)
#pragma unroll
            for (int m = 0; m < 4; ++m) { if (u.half >= 0 && ai != u.half) continue; const size_t ro = ((size_t)(row0 + ai * HALF + m * 16) * NIN + col0) * 2;
#pragma unroll
                for (int bj = 0; bj < 2; ++bj) { const f32x4 v0 = acc[ai][bj][m][0] * rsv[ai][m], v1 = acc[ai][bj][m][1] * rsv[ai][m];
                    u32x4 w; w.x = cvt_pk_bf16(v0[0], v0[1]); w.y = cvt_pk_bf16(v0[2], v0[3]); w.z = cvt_pk_bf16(v1[0], v1[1]); w.w = cvt_pk_bf16(v1[2], v1[3]);
                    ST16(Z, ro + bj * HALF * 2, w); } }
        if (u.pn == 9) {
#pragma unroll
            for (int ai = 0; ai < 2; ++ai)
#pragma unroll
                for (int m = 0; m < 4; ++m) { if (u.half >= 0 && ai != u.half) continue; const int r = row0 + ai * HALF + m * 16, b = r >> 11, s = r & (SEQ - 1);
#pragma unroll
                    for (int bj = 0; bj < 2; ++bj)
#pragma unroll
                        for (int n = 0; n < 2; ++n)
#pragma unroll
                            for (int e = 0; e < 4; ++e) ST2(VT, (((size_t)((b * 2 + bj) * HD + wc * 32 + 8 * fq + 4 * n + e)) * SEQ + s) * 2, (short)f2bf(acc[ai][bj][m][n][e] * rsv[ai][m])); }
        }
    }
};
struct EpiRes {
    static constexpr bool PERM = true;
    const bf16* base; rsrc_t out;
    __device__ __forceinline__ void operator()(const f32x4 (&acc)[2][2][4][2], const Unit& u, int wr, int wc, int fr, int fq) const {
        const int row0 = u.rbase + wr * 64 + fr, col0 = u.pn * BM + wc * 32 + 8 * fq;
        u32x4 bvs[2][4][2];
#pragma unroll
        for (int ai = 0; ai < 2; ++ai)
#pragma unroll
            for (int m = 0; m < 4; ++m)
#pragma unroll
                for (int bj = 0; bj < 2; ++bj) bvs[ai][m][bj] = *(const u32x4*)(base + (size_t)(row0 + ai * HALF + m * 16) * D + col0 + bj * HALF);
        __builtin_amdgcn_sched_barrier(0);
#pragma unroll
        for (int ai = 0; ai < 2; ++ai)
#pragma unroll
            for (int m = 0; m < 4; ++m) { const size_t off = (size_t)(row0 + ai * HALF + m * 16) * D + col0;
#pragma unroll
                for (int bj = 0; bj < 2; ++bj) { const u32x4 bv = bvs[ai][m][bj]; const f32x4 v0 = acc[ai][bj][m][0], v1 = acc[ai][bj][m][1];
                    u32x4 w; w.x = cvt_pk_bf16(v0[0] + bflo(bv.x), v0[1] + bfhi(bv.x)); w.y = cvt_pk_bf16(v0[2] + bflo(bv.y), v0[3] + bfhi(bv.y)); w.z = cvt_pk_bf16(v1[0] + bflo(bv.z), v1[1] + bfhi(bv.z)); w.w = cvt_pk_bf16(v1[2] + bflo(bv.w), v1[3] + bfhi(bv.w));
                    ST16(out, (off + bj * HALF) * 2, w); } }
    }
};
struct EpiSilu {
    static constexpr bool PERM = true;
    rsrc_t ABUF; const int* LIST; const float* RS;
    __device__ __forceinline__ void operator()(const f32x4 (&acc)[2][2][4][2], const Unit& u, int wr, int wc, int fr, int fq) const {
        const int rl0 = wr * 64 + fr, col0 = u.pn * HALF + wc * 32 + 8 * fq;
        const int* lst = LIST + (size_t)u.e * T + u.pm * BM;
        int toks[2][4]; float rs[2][4];
#pragma unroll
        for (int ai = 0; ai < 2; ++ai)
#pragma unroll
            for (int m = 0; m < 4; ++m) { const int rl = rl0 + ai * HALF + m * 16; toks[ai][m] = lst[rl < u.rows ? rl : u.rows - 1] >> 1; }
        __builtin_amdgcn_sched_barrier(0);
#pragma unroll
        for (int ai = 0; ai < 2; ++ai)
#pragma unroll
            for (int m = 0; m < 4; ++m) rs[ai][m] = RS[toks[ai][m]];
        __builtin_amdgcn_sched_barrier(0);
#pragma unroll
        for (int ai = 0; ai < 2; ++ai)
#pragma unroll
            for (int m = 0; m < 4; ++m) { const int rl = rl0 + ai * HALF + m * 16;
                if (rl < u.rows) { float a[8]; const float r_ = rs[ai][m];
#pragma unroll
                    for (int n = 0; n < 2; ++n)
#pragma unroll
                        for (int e = 0; e < 4; ++e) { const float g = acc[ai][0][m][n][e] * r_, up = acc[ai][1][m][n][e] * r_;
                            a[n * 4 + e] = g * __builtin_amdgcn_rcpf(1.0f + __builtin_amdgcn_exp2f(-1.4426950408889634f * g)) * up; }
                    u32x4 w; w.x = cvt_pk_bf16(a[0], a[1]); w.y = cvt_pk_bf16(a[2], a[3]); w.z = cvt_pk_bf16(a[4], a[5]); w.w = cvt_pk_bf16(a[6], a[7]);
                    ST16(ABUF, ((size_t)(u.rbase + rl) * DEXP + col0) * 2, w); } }
    }
};
struct EpiScatter {
    static constexpr bool PERM = true;
    rsrc_t Y; const int* LIST; const float* CW;
    __device__ __forceinline__ void operator()(const f32x4 (&acc)[2][2][4][2], const Unit& u, int wr, int wc, int fr, int fq) const {
        const int rl0 = wr * 64 + fr, col0 = u.pn * BM + wc * 32 + 8 * fq;
        const int* lst = LIST + (size_t)u.e * T + u.pm * BM;
        int slots[2][4]; float cws[2][4];
#pragma unroll
        for (int ai = 0; ai < 2; ++ai)
#pragma unroll
            for (int m = 0; m < 4; ++m) { const int rl = rl0 + ai * HALF + m * 16; slots[ai][m] = lst[rl < u.rows ? rl : u.rows - 1]; }
        __builtin_amdgcn_sched_barrier(0);
#pragma unroll
        for (int ai = 0; ai < 2; ++ai)
#pragma unroll
            for (int m = 0; m < 4; ++m) cws[ai][m] = CW[slots[ai][m]];
        __builtin_amdgcn_sched_barrier(0);
#pragma unroll
        for (int ai = 0; ai < 2; ++ai)
#pragma unroll
            for (int m = 0; m < 4; ++m) { const int rl = rl0 + ai * HALF + m * 16;
                if (rl < u.rows) { const int slot = slots[ai][m]; const float c = cws[ai][m]; const size_t ro = ((size_t)slot * D + col0) * 2;
#pragma unroll
                    for (int bj = 0; bj < 2; ++bj) { const f32x4 v0 = acc[ai][bj][m][0] * c, v1 = acc[ai][bj][m][1] * c;
                        u32x4 w; w.x = cvt_pk_bf16(v0[0], v0[1]); w.y = cvt_pk_bf16(v0[2], v0[3]); w.z = cvt_pk_bf16(v1[0], v1[1]); w.w = cvt_pk_bf16(v1[2], v1[3]);
                        ST16(Y, ro + bj * HALF * 2, w); } }
            }
    }
};

template <class Epi, class Sched, bool GATHER>
__device__ __forceinline__ void gemm_phase(LAS unsigned char* lds, const int tid, const int K, const Sched& S, const Epi& E) {
    const int wid = __builtin_amdgcn_readfirstlane(tid >> 6), lane = tid & 63, wr = wid >> 2, wc = wid & 3, fr = lane & 15, fq = lane >> 4;
    const int nt = K / BK;
    unsigned voffB[2];
#pragma unroll
    for (int i = 0; i < 2; ++i) { int R, C; stage_rc(tid * 16 + i * 8192, R, C); const int Rb = Epi::PERM ? ((R & ~31) + perm32(R & 31)) : R; voffB[i] = (unsigned)(Rb * K + C) * 2u; }
    const size_t kstep = (size_t)(BK * 2);
    const size_t hstepB = (size_t)HALF * K * 2;
    const unsigned ldsw = (unsigned)wid * 1024u;
    const int aoff = lds_byte(wr * 64 + fr, fq * 8), boff = lds_byte(wc * 32 + fr, fq * 8);
#define PG8_SA(b, h) (((b) * 2 + (h)) * HTB)
#define PG8_SB(b, h) ((4 + (b) * 2 + (h)) * HTB)
#define PG8_STAGE_B(bufoff, gbase) do { _Pragma("unroll") for (int _i = 0; _i < 2; ++_i) \
        __builtin_amdgcn_global_load_lds((const unsigned*)((const char*)(gbase) + voffB[_i]), (LAS unsigned*)(lds + (bufoff) + ldsw + _i * 8192), 16, 0, 0); } while (0)
#define PG8_STAGE_A(bufoff, gbase, v, h) do { _Pragma("unroll") for (int _i = 0; _i < 2; ++_i) \
        __builtin_amdgcn_global_load_lds((const unsigned*)((const char*)(gbase) + (v)[h][_i]), (LAS unsigned*)(lds + (bufoff) + ldsw + _i * 8192), 16, 0, 0); } while (0)
#define PG8_AOFF(u, v) do { int _t = tid; asm volatile("" : "+v"(_t)); _Pragma("unroll") for (int _i = 0; _i < 2; ++_i) { int _R, _C; stage_rc(_t * 16 + _i * 8192, _R, _C); \
        _Pragma("unroll") for (int _h = 0; _h < 2; ++_h) { const int _r = _h * HALF + _R; \
        (v)[_h][_i] = GATHER ? (S.gather_off((u), _r) + (unsigned)_C * 2u) : (unsigned)(_r * K + _C) * 2u; } } } while (0)
#define PG8_LDA(dst, b, h) do { _Pragma("unroll") for (int m = 0; m < 4; ++m) _Pragma("unroll") for (int k = 0; k < 2; ++k) dst[m][k] = *(const LAS bf16x8*)(lds + PG8_SA(b, h) + aoff + m * 2048 + k * 1024); } while (0)
#define PG8_LDB(dst, b, h) do { _Pragma("unroll") for (int n = 0; n < 2; ++n) _Pragma("unroll") for (int k = 0; k < 2; ++k) dst[n][k] = *(const LAS bf16x8*)(lds + PG8_SB(b, h) + boff + n * 2048 + k * 1024); } while (0)
#define PG8_MMA(ai, bj, At, Bt) do { __builtin_amdgcn_s_setprio(1); _Pragma("unroll") for (int m = 0; m < 4; ++m) _Pragma("unroll") for (int n = 0; n < 2; ++n) _Pragma("unroll") for (int k = 0; k < 2; ++k) \
        acc[ai][bj][m][n] = __builtin_amdgcn_mfma_f32_16x16x32_bf16(Bt[n][k], At[m][k], acc[ai][bj][m][n], 0, 0, 0); __builtin_amdgcn_s_setprio(0); } while (0)
#define PG8_WAIT_V(n) asm volatile("s_waitcnt vmcnt(" #n ")" ::: "memory")
#define PG8_WAIT_L(n) asm volatile("s_waitcnt lgkmcnt(" #n ")" ::: "memory")
#define PG8_BAR __builtin_amdgcn_s_barrier()
#define PG8_SCHED __builtin_amdgcn_sched_barrier(0)
    Unit cur, nxt; int ui = 0;
    if (!S.next(0, cur)) return;
    f32x4 acc[2][2][4][2];
#pragma unroll
    for (int a = 0; a < 2; ++a)
#pragma unroll
        for (int b = 0; b < 2; ++b)
#pragma unroll
            for (int m = 0; m < 4; ++m)
#pragma unroll
                for (int n = 0; n < 2; ++n) acc[a][b][m][n] = (f32x4){0.f, 0.f, 0.f, 0.f};
    bf16x8 At[4][2], B0[2][2], B1[2][2];
    unsigned vA[2][2], vN[2][2];
    PG8_AOFF(cur, vA);
    const char* cA = cur.a; const char* cB = cur.b;
    PG8_STAGE_B(PG8_SB(0, 0), cB); PG8_STAGE_B(PG8_SB(0, 1), cB + hstepB); PG8_STAGE_A(PG8_SA(0, 0), cA, vA, 0); PG8_STAGE_A(PG8_SA(0, 1), cA, vA, 1);
    if (wr == 1) PG8_BAR;
    PG8_WAIT_V(2); PG8_BAR;
    PG8_STAGE_B(PG8_SB(1, 0), cB + kstep); PG8_STAGE_A(PG8_SA(1, 0), cA + kstep, vA, 0); PG8_STAGE_B(PG8_SB(1, 1), cB + hstepB + kstep);
    PG8_WAIT_V(6); PG8_BAR;
    for (;;) {
        const bool has_next = S.next(ui + 1, nxt);
        const char* nA = has_next ? nxt.a : cA; const char* nB = has_next ? nxt.b : cB;
        if (GATHER) { if (has_next) { PG8_AOFF(nxt, vN); } else {
#pragma unroll
            for (int h = 0; h < 2; ++h)
#pragma unroll
                for (int i = 0; i < 2; ++i) vN[h][i] = vA[h][i]; } }
        for (int t = 0; t < nt; t += 2) {
            const bool last = (t == nt - 2);
            const char* a1 = cA + (size_t)(t + 1) * kstep;
            const char* a2 = last ? nA : cA + (size_t)(t + 2) * kstep; const char* b2 = last ? nB : cB + (size_t)(t + 2) * kstep;
            const char* a3 = a2 + kstep; const char* b3 = b2 + kstep;
            unsigned v2[2][2];
#pragma unroll
            for (int h = 0; h < 2; ++h)
#pragma unroll
                for (int i = 0; i < 2; ++i) v2[h][i] = (GATHER && last) ? vN[h][i] : vA[h][i];
            PG8_LDB(B0, 0, 0); PG8_LDB(B1, 0, 1); PG8_SCHED; PG8_LDA(At, 0, 0); PG8_STAGE_A(PG8_SA(1, 1), a1, vA, 1);
            PG8_WAIT_V(8); PG8_WAIT_L(0); PG8_BAR; if (cur.half != 1) { PG8_MMA(0, 0, At, B0); PG8_MMA(0, 1, At, B1); } PG8_BAR; PG8_SCHED;
            PG8_LDA(At, 0, 1); PG8_STAGE_B(PG8_SB(0, 0), b2); PG8_STAGE_B(PG8_SB(0, 1), b2 + hstepB); PG8_STAGE_A(PG8_SA(0, 0), a2, v2, 0);
            PG8_WAIT_V(8); PG8_WAIT_L(0); PG8_BAR; if (cur.half != 0) { PG8_MMA(1, 0, At, B0); PG8_MMA(1, 1, At, B1); } PG8_BAR; PG8_SCHED;
            PG8_LDB(B0, 1, 0); PG8_LDB(B1, 1, 1); PG8_SCHED; PG8_LDA(At, 1, 0); PG8_STAGE_A(PG8_SA(0, 1), a2, v2, 1);
            PG8_WAIT_V(8); PG8_WAIT_L(0); PG8_BAR; if (cur.half != 1) { PG8_MMA(0, 0, At, B0); PG8_MMA(0, 1, At, B1); } PG8_BAR; PG8_SCHED;
            PG8_LDA(At, 1, 1); PG8_STAGE_B(PG8_SB(1, 0), b3); PG8_STAGE_B(PG8_SB(1, 1), b3 + hstepB); PG8_STAGE_A(PG8_SA(1, 0), a3, v2, 0);
            PG8_WAIT_V(8); PG8_WAIT_L(0); PG8_BAR; if (cur.half != 0) { PG8_MMA(1, 0, At, B0); PG8_MMA(1, 1, At, B1); } PG8_BAR; PG8_SCHED;
        }
        if (wr == 0) PG8_BAR;
        E(acc, cur, wr, wc, fr, fq);
        if (!has_next) break;
#pragma unroll
        for (int a = 0; a < 2; ++a)
#pragma unroll
            for (int b = 0; b < 2; ++b)
#pragma unroll
                for (int m = 0; m < 4; ++m)
#pragma unroll
                    for (int n = 0; n < 2; ++n) acc[a][b][m][n] = (f32x4){0.f, 0.f, 0.f, 0.f};
        cur = nxt; cA = nA; cB = nB; ++ui;
#pragma unroll
        for (int h = 0; h < 2; ++h)
#pragma unroll
            for (int i = 0; i < 2; ++i) vA[h][i] = GATHER ? vN[h][i] : vA[h][i];
        if (wr == 1) PG8_BAR;
    }
    PG8_WAIT_V(0);
    PG8_BAR;
#undef PG8_SA
#undef PG8_SB
#undef PG8_STAGE_A
#undef PG8_STAGE_B
#undef PG8_AOFF
#undef PG8_LDA
#undef PG8_LDB
#undef PG8_MMA
#undef PG8_WAIT_V
#undef PG8_WAIT_L
#undef PG8_BAR
#undef PG8_SCHED
}
}

template <bool FRAG = false>
__device__ __forceinline__ void transpose_item(const float* W, int K, int N, bf16* WT, int k0, int n0, int drow0, LAS float* scr, int lane, const float* gk = nullptr) {
#pragma unroll
    for (int i = 0; i < 8; ++i) { const int kk = 8 * i + (lane >> 3), c4 = 4 * (lane & 7);
        f32x4 v = *(const f32x4*)(W + (size_t)(k0 + kk) * N + n0 + c4);
        if (gk) v = v * gk[k0 + kk];
        LAS float* d = scr + kk * 33 + c4; d[0] = v.x; d[1] = v.y; d[2] = v.z; d[3] = v.w; }
    asm volatile("s_waitcnt lgkmcnt(0)" ::: "memory");
    const int c = lane & 7;
#pragma unroll
    for (int j = 0; j < 4; ++j) { const int n = (lane >> 3) + 8 * j; const LAS float* s = scr + (8 * c) * 33 + n;
        v4u o; o.x = pk2(s[0 * 33], s[1 * 33]); o.y = pk2(s[2 * 33], s[3 * 33]); o.z = pk2(s[4 * 33], s[5 * 33]); o.w = pk2(s[6 * 33], s[7 * 33]);
        if (FRAG) { const int d = drow0 + n, k8 = (k0 >> 3) + c;
            *(v4u*)(WT + ((size_t)(((d >> 5) * (K >> 4) + (k8 >> 1)) * 64 + 32 * (k8 & 1) + (d & 31))) * 8) = o; }
        else *(v4u*)(WT + (size_t)(drow0 + n) * K + k0 + 8 * c) = o; }
    asm volatile("s_waitcnt lgkmcnt(0)" ::: "memory");
}
__device__ __forceinline__ void p_prologue(Frame& F) {
    p_prologue_rows(F);
    LAS float* scr = (LAS float*)(F.lds + F.wave * 16384);
    const int gw = F.bid * NWAVES + F.wave, NGW = F.G * NWAVES;
    constexpr int I_IN = (D / 64) * (NIN / 32), I_OUT = (D / 64) * (D / 32), I_G = (D / 64) * (DEXP / 32), I_D = (DEXP / 64) * (D / 32), I_E = 2 * I_G + I_D, LAY = I_IN + I_OUT + NEXP * I_E;
    for (int it = gw; it < DEPTH * LAY; it += NGW) {
        const int l = it / LAY; int r = it % LAY;
        if (r < I_IN) { const int nb = NIN / 32, kb = r / nb, n0 = 32 * (r % nb); transpose_item(F.w_in + (size_t)l * D * NIN, D, NIN, F.WIN_T + (size_t)l * NIN * D, 64 * kb, n0, n0, scr, F.lane, F.norm_mix + (size_t)l * D); continue; }
        r -= I_IN;
        if (r < I_OUT) { const int nb = D / 32, kb = r / nb, n0 = 32 * (r % nb); transpose_item(F.w_out + (size_t)l * D * D, D, D, F.WOUT_T + (size_t)l * D * D, 64 * kb, n0, n0, scr, F.lane); continue; }
        r -= I_OUT;
        const int e = r / I_E; int q = r % I_E; const size_t le = (size_t)(l * NEXP + e);
        if (q < 2 * I_G) { const int up = q >= I_G; q -= up * I_G; const int nb = DEXP / 32, kb = q / nb, n0 = 32 * (q % nb);
            transpose_item((up ? F.w_up : F.w_gate) + le * D * DEXP, D, DEXP, F.WGU_T + le * 2 * DEXP * D, 64 * kb, n0, ((n0 >> 7) << 8) + up * 128 + (n0 & 127), scr, F.lane, F.norm_ffn + (size_t)l * D); continue; }
        q -= 2 * I_G;
        { const int nb = D / 32, kb = q / nb, n0 = 32 * (q % nb); transpose_item(F.w_down + le * DEXP * D, DEXP, D, F.WD_T + le * D * DEXP, 64 * kb, n0, n0, scr, F.lane); }
    }
    for (int it = gw; it < DEPTH * 4 * 32; it += NGW) {
        const int lg = it >> 5, q = it & 31, kb = q >> 3, n0 = 32 * (q & 7);
        transpose_item<true>(F.w_pool + (size_t)lg * 65536, 256, 256, F.WP_T + (size_t)lg * 65536, 64 * kb, n0, n0, scr, F.lane);
    }
    const rsrc_t wrb = mk_rsrc(F.WR_T, MiB), ropeb = mk_rsrc(F.ROPE, 2 * MiB);
    for (int idx = F.bid * NTHREADS + F.tid; idx < DEPTH * 64 * D; idx += F.G * NTHREADS) {
        const int l = idx / (64 * D), col = (idx / D) & 63, k = idx & (D - 1);
        float v = 0.f;
        if (col < NEXP) v = F.w_re[((size_t)l * D + k) * NEXP + col]; else if (col < NEXP + 4) v = F.w_rg[((size_t)l * D + k) * 4 + (col - NEXP)];
        v *= F.norm_ffn[l * D + k];
        const unsigned h = f2bf(v); const float r = v - bf2f((bf16)h);
        const size_t fo = (((size_t)((col >> 5) * 4 + (k >> 9)) * 32 + ((k >> 4) & 31)) * 64 + 32 * ((k >> 3) & 1) + (col & 31)) * 8 + (k & 7);
        ST2(wrb, ((size_t)(l * 2 + 0) * 64 * D + fo) * 2, (short)h); ST2(wrb, ((size_t)(l * 2 + 1) * 64 * D + fo) * 2, (short)f2bf(r));
    }
    for (int idx = F.bid * NTHREADS + F.tid; idx < T * 16; idx += F.G * NTHREADS) {
        const int t = idx >> 4, i = idx & 15;
        const float f = exp2f(-(float)i * (18.931568569324174f / 16.0f)) * 0.15915494309189535f;
        const float p = (float)F.pos[t], hi = p * f, lo = fmaf(p, f, -hi);
        float rev = (hi - floorf(hi)) + lo;
        ST4(ropeb, ((size_t)t * 32 + i) * 4, __builtin_bit_cast(unsigned, __builtin_amdgcn_cosf(rev))); ST4(ropeb, ((size_t)t * 32 + 16 + i) * 4, __builtin_bit_cast(unsigned, __builtin_amdgcn_sinf(rev)));
    }
    __syncthreads();
}

__device__ __forceinline__ void p_gemm1(Frame& F, int l) {
    pg8::DenseOrder S; S.init(F.XRB, F.WIN_T + (size_t)l * NIN * D, T, NIN, D, F.G, F.bid);
    pg8::EpiZ E{mk_rsrc(F.Z, (size_t)T * NIN * 2), mk_rsrc(F.VT, (size_t)T * KVW * 2), l};
    pg8::gemm_phase<pg8::EpiZ, pg8::DenseOrder, false>(F.lds, F.tid, D, S, E);
}
__device__ __forceinline__ void p_gemm2(Frame& F, int l) {
    pg8::DenseOrder S; S.init(F.MIX, F.WOUT_T + (size_t)l * D * D, T, D, D, F.G, F.bid);
    pg8::EpiRes E{F.XRB, mk_rsrc(F.X1B, (size_t)T * D * 2)};
    pg8::gemm_phase<pg8::EpiRes, pg8::DenseOrder, false>(F.lds, F.tid, D, S, E);
}
__device__ __forceinline__ void p_moe_gu(Frame& F, int l) {
    load_counts(F, l, 2 * DEXP / 256);
    pg8::MoeOrder S; S.cnt_s = (const LAS int*)(F.lds + CNT_OFF); S.base_s = (const LAS int*)(F.lds + BASE_OFF); S.ustart = (const LAS int*)(F.lds + USTART_OFF);
    S.nN = 2 * DEXP / 256; S.G = F.G; S.c = F.bid; S.K = D; S.total = __builtin_amdgcn_readfirstlane(S.ustart[32]); S.gather = 1; S.A = (const char*)F.X1B; S.Bt = (const char*)(F.WGU_T + (size_t)l * NEXP * 2 * DEXP * D); S.b_estride = (size_t)2 * DEXP * D * 2; S.LIST = F.LIST;
    pg8::EpiSilu E{mk_rsrc(F.ABUF, (size_t)40960 * DEXP * 2), F.LIST, F.RS2};
    pg8::gemm_phase<pg8::EpiSilu, pg8::MoeOrder, true>(F.lds, F.tid, D, S, E);
}
__device__ __forceinline__ void p_moe_dn(Frame& F, int l) {
    load_counts(F, l, D / 256);
    pg8::MoeOrder S; S.cnt_s = (const LAS int*)(F.lds + CNT_OFF); S.base_s = (const LAS int*)(F.lds + BASE_OFF); S.ustart = (const LAS int*)(F.lds + USTART_OFF);
    S.nN = D / 256; S.G = F.G; S.c = F.bid; S.K = DEXP; S.total = __builtin_amdgcn_readfirstlane(S.ustart[32]); S.gather = 0; S.A = (const char*)F.ABUF; S.Bt = (const char*)(F.WD_T + (size_t)l * NEXP * D * DEXP); S.b_estride = (size_t)D * DEXP * 2; S.LIST = F.LIST;
    pg8::EpiScatter E{mk_rsrc(F.Y, (size_t)2 * T * D * 2), F.LIST, F.CW};
    pg8::gemm_phase<pg8::EpiScatter, pg8::MoeOrder, false>(F.lds, F.tid, DEXP, S, E);
}


typedef float f32x2_t __attribute__((ext_vector_type(2)));
typedef __bf16 bf16x2_t __attribute__((ext_vector_type(2)));
__device__ __forceinline__ unsigned cvtpk(float lo, float hi) { f32x2_t v = {lo, hi}; bf16x2_t b = __builtin_convertvector(v, bf16x2_t); return __builtin_bit_cast(unsigned, b); }
constexpr int MX_KP = 136, MX_VP = 36, MX_YP = 1032;
constexpr int MX_KBUF = 0, MX_KSTAGE = 2 * 32 * MX_KP * 2;
constexpr int MX_VBUF = 2 * MX_KSTAGE, MX_VSTAGE = 2 * 128 * MX_VP * 2;
constexpr int MX_YT = 0;
constexpr int MX_REDA = 122880, MX_REDP = MX_REDA + 1024;
constexpr int MX_OSTP = 272, MX_OSTW = 32 * MX_OSTP;
static_assert(MX_VBUF + 2 * MX_VSTAGE <= MX_REDA && 32 * MX_YP * 2 <= MX_REDA && 8 * MX_OSTW <= MX_REDA, "mixer LDS map");
__device__ __forceinline__ void mx_flush_tile(LAS unsigned char* tile, rsrc_t mix, size_t gbyte, int lane) {
    asm volatile("s_waitcnt lgkmcnt(0)" ::: "memory");
    const int rr = lane >> 4, cc = lane & 15;
#pragma unroll
    for (int k = 0; k < 8; ++k) { const v4u v = *(const LAS v4u*)(tile + (rr + 4 * k) * MX_OSTP + 16 * cc); ST16(mix, gbyte + ((size_t)(rr + 4 * k) * D + 8 * cc) * 2, v); }
}
template <int HW>
__device__ __forceinline__ void mx_ytile(const bf16* Z, LAS unsigned char* lds, int b, int s0, int w, int lane) {
    constexpr int NJ = 7 + 2 * HW;
    const int c = 32 * (w >> 1) + (lane & 31), r0 = 8 * (2 * (w & 1) + (lane >> 5)), sb = s0 + r0;
    const bf16* base = Z + (size_t)(b * SEQ) * NIN + 8 * c;
    v4u raw[NJ];
#pragma unroll
    for (int j = 0; j < NJ; ++j) { const int row = sb - HW + j; const bool ok = (unsigned)row < (unsigned)SEQ;
        v4u t = *(const v4u*)(base + (size_t)(ok ? row : sb) * NIN);
        t.x = ok ? t.x : 0u; t.y = ok ? t.y : 0u; t.z = ok ? t.z : 0u; t.w = ok ? t.w : 0u; raw[j] = t; }
    float a[8];
#pragma unroll
    for (int e = 0; e < 8; ++e) a[e] = 0.f;
#pragma unroll
    for (int j = 0; j < 2 * HW; ++j) { a[0] += bflo(raw[j].x); a[1] += bfhi(raw[j].x); a[2] += bflo(raw[j].y); a[3] += bfhi(raw[j].y); a[4] += bflo(raw[j].z); a[5] += bfhi(raw[j].z); a[6] += bflo(raw[j].w); a[7] += bfhi(raw[j].w); }
#pragma unroll
    for (int i = 0; i < 8; ++i) {
        const int s = sb + i, lo = s - HW < 0 ? 0 : s - HW, hi_ = s + HW > SEQ ? SEQ : s + HW;
        const float inv = 1.0f / (float)(hi_ - lo);
        const v4u cr = raw[HW + i];
        v4u pk; pk.x = cvtpk(a[0] * inv - bflo(cr.x), a[1] * inv - bfhi(cr.x)); pk.y = cvtpk(a[2] * inv - bflo(cr.y), a[3] * inv - bfhi(cr.y));
        pk.z = cvtpk(a[4] * inv - bflo(cr.z), a[5] * inv - bfhi(cr.z)); pk.w = cvtpk(a[6] * inv - bflo(cr.w), a[7] * inv - bfhi(cr.w));
        *(LAS v4u*)(lds + MX_YT + ((r0 + i) * MX_YP + 8 * c) * 2) = pk;
        if (i < 7) { const v4u p = raw[i + 2 * HW], q = raw[i];
            a[0] += bflo(p.x) - bflo(q.x); a[1] += bfhi(p.x) - bfhi(q.x); a[2] += bflo(p.y) - bflo(q.y); a[3] += bfhi(p.y) - bfhi(q.y);
            a[4] += bflo(p.z) - bflo(q.z); a[5] += bfhi(p.z) - bfhi(q.z); a[6] += bflo(p.w) - bflo(q.w); a[7] += bfhi(p.w) - bfhi(q.w); }
    }
}
__device__ __forceinline__ void p_mix(Frame& F, int l) {
    const rsrc_t mixb = mk_rsrc(F.MIX, (size_t)T * D * 2);
    const int w = F.wave, kvh = w >> 2;
    LAS unsigned char* lds = F.lds;
    LAS float* redA = (LAS float*)(lds + MX_REDA); LAS float* redP = (LAS float*)(lds + MX_REDP);
    const float LOG2E = 1.4426950408889634f;
    const float sinkv = F.sink[l * NQH + w] * LOG2E;
    const int vcu = (F.G % 8 == 0) ? (F.bid % 8) * (F.G / 8) + F.bid / 8 : F.bid;
    const int per = (T / 32 + F.G - 1) / F.G;
    for (int ii = 0; ii < per; ++ii) {
        const int it = vcu * per + ii;
        if (it >= T / 32) break;
        int tid = F.tid; asm volatile("" : "+v"(tid));
        const int lane = tid & 63, r32 = lane & 31, hi = lane >> 5;
        const int skey = tid >> 4, sc = tid & 15, vdim = tid >> 2, vc = tid & 3;
        const int t0 = it * 32, b = t0 >> 11, s0 = t0 & (SEQ - 1);
        const int kt_lo = (s0 >= 128) ? 0 : ((128 - s0) >> 5);
        const int kt_hi = ((SEQ + 96 - s0) >> 5) > 8 ? 8 : ((SEQ + 96 - s0) >> 5);
        bf16x8 qf[8];
        {
            const bf16* qrow = F.Z + (size_t)(t0 + r32) * NIN + POOLW + w * HD + 8 * hi;
            float qv[8][8]; float ssq = 0.f;
#pragma unroll
            for (int s = 0; s < 8; ++s) { const v4u raw = *(const v4u*)(qrow + 16 * s);
                qv[s][0] = bflo(raw.x); qv[s][1] = bfhi(raw.x); qv[s][2] = bflo(raw.y); qv[s][3] = bfhi(raw.y); qv[s][4] = bflo(raw.z); qv[s][5] = bfhi(raw.z); qv[s][6] = bflo(raw.w); qv[s][7] = bfhi(raw.w);
#pragma unroll
                for (int j = 0; j < 8; ++j) ssq += qv[s][j] * qv[s][j]; }
            ssq += __shfl_xor(ssq, 32);
            const float rstd = (0.08838834764831845f * LOG2E) / sqrtf(ssq * (1.0f / HD) + EPS);
            const float* qn = F.q_norm + l * HD + 8 * hi;
#pragma unroll
            for (int s = 0; s < 8; ++s) { const f32x4 g0 = *(const f32x4*)(qn + 16 * s), g1 = *(const f32x4*)(qn + 16 * s + 4);
                qv[s][0] *= rstd * g0.x; qv[s][1] *= rstd * g0.y; qv[s][2] *= rstd * g0.z; qv[s][3] *= rstd * g0.w; qv[s][4] *= rstd * g1.x; qv[s][5] *= rstd * g1.y; qv[s][6] *= rstd * g1.z; qv[s][7] *= rstd * g1.w; }
            const float* rp = F.ROPE + (size_t)(t0 + r32) * 32 + 8 * hi;
            const f32x4 c0 = *(const f32x4*)rp, c1 = *(const f32x4*)(rp + 4), s0v = *(const f32x4*)(rp + 16), s1v = *(const f32x4*)(rp + 20);
            const float cs[8] = {c0.x, c0.y, c0.z, c0.w, c1.x, c1.y, c1.z, c1.w}, sn[8] = {s0v.x, s0v.y, s0v.z, s0v.w, s1v.x, s1v.y, s1v.z, s1v.w};
#pragma unroll
            for (int j = 0; j < 8; ++j) { const float x1 = qv[0][j], x2 = qv[1][j]; qv[0][j] = x1 * cs[j] - x2 * sn[j]; qv[1][j] = x2 * cs[j] + x1 * sn[j]; }
#pragma unroll
            for (int s = 0; s < 8; ++s) { v4u pk; pk.x = cvtpk(qv[s][0], qv[s][1]); pk.y = cvtpk(qv[s][2], qv[s][3]); pk.z = cvtpk(qv[s][4], qv[s][5]); pk.w = cvtpk(qv[s][6], qv[s][7]); qf[s] = __builtin_bit_cast(bf16x8, pk); }
        }
        f32x16 O[4];
#pragma unroll
        for (int db = 0; db < 4; ++db)
#pragma unroll
            for (int i = 0; i < 16; ++i) O[db][i] = 0.f;
        float m = sinkv, lsum = 1.0f;
        v4u kraw0, kraw1, vraw0, vraw1;
#define MX_LOAD(kt) do { const int ks_ = s0 - 128 + 32 * (kt); const size_t krow_ = (size_t)(b * SEQ + ks_ + skey); \
            kraw0 = *(const v4u*)(F.Z + krow_ * NIN + POOLW + ATTW + 8 * sc); kraw1 = *(const v4u*)(F.Z + krow_ * NIN + POOLW + ATTW + HD + 8 * sc); \
            vraw0 = *(const v4u*)(F.VT + ((size_t)((b * 2 + 0) * HD + vdim)) * SEQ + ks_ + 8 * vc); vraw1 = *(const v4u*)(F.VT + ((size_t)((b * 2 + 1) * HD + vdim)) * SEQ + ks_ + 8 * vc); } while (0)
#define MX_KROW(raw, kv, sb) do { *(LAS v4u*)(lds + MX_KBUF + (sb) * MX_KSTAGE + (((kv) * 32 + skey) * MX_KP + 8 * sc) * 2) = raw; } while (0)
#define MX_STORE(sb) do { MX_KROW(kraw0, 0, sb); MX_KROW(kraw1, 1, sb); \
            { LAS unsigned char* vp_ = lds + MX_VBUF + (sb) * MX_VSTAGE + ((0 * 128 + vdim) * MX_VP + 8 * vc) * 2; v2u a_; a_.x = vraw0.x; a_.y = vraw0.y; *(LAS v2u*)vp_ = a_; a_.x = vraw0.z; a_.y = vraw0.w; *(LAS v2u*)(vp_ + 8) = a_; } \
            { LAS unsigned char* vp_ = lds + MX_VBUF + (sb) * MX_VSTAGE + ((1 * 128 + vdim) * MX_VP + 8 * vc) * 2; v2u a_; a_.x = vraw1.x; a_.y = vraw1.y; *(LAS v2u*)vp_ = a_; a_.x = vraw1.z; a_.y = vraw1.w; *(LAS v2u*)(vp_ + 8) = a_; } } while (0)
        MX_LOAD(kt_lo);
        for (int kt = kt_lo; kt <= kt_hi; ++kt) {
            const int sb = (kt - kt_lo) & 1;
            MX_STORE(sb);
            if (kt < kt_hi) MX_LOAD(kt + 1);
            __syncthreads();
            f32x16 S;
#pragma unroll
            for (int i = 0; i < 16; ++i) S[i] = 0.f;
            const LAS unsigned char* kb = lds + MX_KBUF + sb * MX_KSTAGE + ((kvh * 32 + r32) * MX_KP + 8 * hi) * 2;
            { bf16x8 kf[8];
#pragma unroll
              for (int s = 0; s < 8; ++s) kf[s] = *(const LAS bf16x8*)(kb + 32 * s);
              __builtin_amdgcn_sched_barrier(0);
#pragma unroll
              for (int s = 0; s < 8; ++s) S = MFMA32(kf[s], qf[s], S);
              __builtin_amdgcn_sched_barrier(0); }
            asm volatile("s_nop 7\n\ts_nop 4" : "+v"(S));
            if (kt == 0) {
#pragma unroll
                for (int i = 0; i < 16; ++i) if (crow(i, hi) < r32) S[i] = -INFINITY;
            }
            if (kt == 8) {
#pragma unroll
                for (int i = 0; i < 16; ++i) if (crow(i, hi) > r32) S[i] = -INFINITY;
            }
            float mx = S[0];
#pragma unroll
            for (int i = 1; i < 16; ++i) mx = fmaxf(mx, S[i]);
            mx = fmaxf(mx, __shfl_xor(mx, 32));
            const float mn = fmaxf(m, mx), alpha = __builtin_amdgcn_exp2f(m - mn);
            float p[16]; float rs = 0.f;
#pragma unroll
            for (int i = 0; i < 16; ++i) { p[i] = __builtin_amdgcn_exp2f(S[i] - mn); rs += p[i]; }
            rs += __shfl_xor(rs, 32);
            lsum = lsum * alpha + rs; m = mn;
#pragma unroll
            for (int db = 0; db < 4; ++db) O[db] = O[db] * alpha;
            v4u pk0, pk1;
            pk0.x = cvtpk(p[0], p[1]); pk0.y = cvtpk(p[2], p[3]); pk0.z = cvtpk(p[4], p[5]); pk0.w = cvtpk(p[6], p[7]);
            pk1.x = cvtpk(p[8], p[9]); pk1.y = cvtpk(p[10], p[11]); pk1.z = cvtpk(p[12], p[13]); pk1.w = cvtpk(p[14], p[15]);
            const bf16x8 pf0 = __builtin_bit_cast(bf16x8, pk0), pf1 = __builtin_bit_cast(bf16x8, pk1);
            const LAS unsigned char* vb = lds + MX_VBUF + sb * MX_VSTAGE + ((kvh * 128 + r32) * MX_VP + 4 * hi) * 2;
            { v4u vv[4][2];
#pragma unroll
              for (int db = 0; db < 4; ++db)
#pragma unroll
                for (int s2 = 0; s2 < 2; ++s2) {
                    const v2u lo8 = *(const LAS v2u*)(vb + (32 * db * MX_VP + 16 * s2) * 2), hi8 = *(const LAS v2u*)(vb + (32 * db * MX_VP + 16 * s2 + 8) * 2);
                    vv[db][s2].x = lo8.x; vv[db][s2].y = lo8.y; vv[db][s2].z = hi8.x; vv[db][s2].w = hi8.y; }
              __builtin_amdgcn_sched_barrier(0);
#pragma unroll
              for (int db = 0; db < 4; ++db)
#pragma unroll
                for (int s2 = 0; s2 < 2; ++s2) O[db] = MFMA32(__builtin_bit_cast(bf16x8, vv[db][s2]), s2 ? pf1 : pf0, O[db]);
              __builtin_amdgcn_sched_barrier(0); }
        }
#undef MX_LOAD
#undef MX_KROW
#undef MX_STORE
        {
            const float inv = 1.0f / lsum; float ss = 0.f;
#pragma unroll
            for (int db = 0; db < 4; ++db) { O[db] = O[db] * inv;
#pragma unroll
                for (int i = 0; i < 16; ++i) ss += O[db][i] * O[db][i]; }
            ss += __shfl_xor(ss, 32);
            if (hi == 0) redA[w * 32 + r32] = ss;
        }
        __syncthreads();
        {
            float tot = 0.f;
#pragma unroll
            for (int h8 = 0; h8 < 8; ++h8) tot += redA[h8 * 32 + r32];
            const float rstd_a = 1.0f / sqrtf(tot * (1.0f / ATTW) + EPS);
            const float* ga = F.g_attn + l * ATTW + w * HD + 4 * hi;
            LAS unsigned char* ost = lds + w * MX_OSTW + r32 * MX_OSTP + 8 * hi;
#pragma unroll
            for (int db = 0; db < 4; ++db)
#pragma unroll
                for (int g4 = 0; g4 < 4; ++g4) { const f32x4 gg = *(const f32x4*)(ga + 32 * db + 8 * g4);
                    v2u o; o.x = cvtpk(O[db][4 * g4 + 0] * rstd_a * gg.x, O[db][4 * g4 + 1] * rstd_a * gg.y); o.y = cvtpk(O[db][4 * g4 + 2] * rstd_a * gg.z, O[db][4 * g4 + 3] * rstd_a * gg.w);
                    *(LAS v2u*)(ost + (32 * db + 8 * g4) * 2) = o; }
            mx_flush_tile(lds + w * MX_OSTW, mixb, ((size_t)t0 * D + POOLW + w * HD) * 2, lane);
        }
        __syncthreads();
        switch (w >> 1) {
            case 0: mx_ytile<1>(F.Z, lds, b, s0, w, lane); break;
            case 1: mx_ytile<2>(F.Z, lds, b, s0, w, lane); break;
            case 2: mx_ytile<4>(F.Z, lds, b, s0, w, lane); break;
            default: mx_ytile<8>(F.Z, lds, b, s0, w, lane); break;
        }
        __syncthreads();
        {
            const int g = w >> 1, ch = w & 1;
            f32x16 acc[4];
#pragma unroll
            for (int cb = 0; cb < 4; ++cb)
#pragma unroll
                for (int i = 0; i < 16; ++i) acc[cb][i] = 0.f;
            const bf16* wp = F.WP_T + (size_t)(l * 4 + g) * 65536 + (size_t)(4 * ch) * 16 * 512 + (size_t)lane * 8;
            const LAS unsigned char* yb = lds + MX_YT + (r32 * MX_YP + 256 * g + 8 * hi) * 2;
            bf16x8 wfa[16], wfb[16];
#pragma unroll
            for (int s = 0; s < 16; ++s) wfa[s] = *(const bf16x8*)(wp + (size_t)s * 512);
            __builtin_amdgcn_sched_barrier(0);
#pragma unroll
            for (int cb = 0; cb < 4; ++cb) {
                if (cb < 3) {
#pragma unroll
                    for (int s = 0; s < 16; ++s) { const bf16x8 t = *(const bf16x8*)(wp + (size_t)((cb + 1) * 16 + s) * 512); if (cb & 1) wfa[s] = t; else wfb[s] = t; }
                }
                __builtin_amdgcn_sched_barrier(0);
#pragma unroll
                for (int s = 0; s < 16; ++s) { const bf16x8 yf = *(const LAS bf16x8*)(yb + 32 * s); acc[cb] = MFMA32((cb & 1) ? wfb[s] : wfa[s], yf, acc[cb]); }
                __builtin_amdgcn_sched_barrier(0);
            }
            const int colb = 256 * g + 128 * ch + 4 * hi;
            const float* ps = F.pool_scale + l * POOLW + colb;
            float ss = 0.f;
#pragma unroll
            for (int cb = 0; cb < 4; ++cb)
#pragma unroll
                for (int g4 = 0; g4 < 4; ++g4) { const f32x4 sc4 = *(const f32x4*)(ps + 32 * cb + 8 * g4);
                    acc[cb][4 * g4 + 0] *= sc4.x; acc[cb][4 * g4 + 1] *= sc4.y; acc[cb][4 * g4 + 2] *= sc4.z; acc[cb][4 * g4 + 3] *= sc4.w;
#pragma unroll
                    for (int e = 0; e < 4; ++e) ss += acc[cb][4 * g4 + e] * acc[cb][4 * g4 + e]; }
            ss += __shfl_xor(ss, 32);
            if (hi == 0) redP[w * 32 + r32] = ss;
            __syncthreads();
            float tot = 0.f;
#pragma unroll
            for (int w8 = 0; w8 < 8; ++w8) tot += redP[w8 * 32 + r32];
            const float rstd_p = 1.0f / sqrtf(tot * (1.0f / POOLW) + EPS);
            const float* gp = F.g_pool + l * POOLW + colb;
            LAS unsigned char* ost = lds + w * MX_OSTW + r32 * MX_OSTP + 8 * hi;
#pragma unroll
            for (int cb = 0; cb < 4; ++cb)
#pragma unroll
                for (int g4 = 0; g4 < 4; ++g4) { const f32x4 gg = *(const f32x4*)(gp + 32 * cb + 8 * g4);
                    v2u o; o.x = cvtpk(acc[cb][4 * g4 + 0] * rstd_p * gg.x, acc[cb][4 * g4 + 1] * rstd_p * gg.y); o.y = cvtpk(acc[cb][4 * g4 + 2] * rstd_p * gg.z, acc[cb][4 * g4 + 3] * rstd_p * gg.w);
                    *(LAS v2u*)(ost + (32 * cb + 8 * g4) * 2) = o; }
            mx_flush_tile(lds + w * MX_OSTW, mixb, ((size_t)t0 * D + 256 * g + 128 * ch) * 2, lane);
        }
        __syncthreads();
    }
    __syncthreads();
}


constexpr int RT_PART = 0;
constexpr int RT_RSTD = 65536;
constexpr int RT_TOKE = 65536 + 256, RT_TOKC = RT_TOKE + 512, RT_TOKP = RT_TOKC + 512, RT_LCNT = RT_TOKP + 512, RT_GBASE = RT_LCNT + 128;
__device__ __forceinline__ void p_router(Frame& F, int l) {
    const RtOut R{F.LIST, F.CW, (unsigned*)(F.ctl + CW_CNT) + l * 32 * 64, nullptr};
    const rsrc_t hb = mk_rsrc(F.HB, (size_t)T * D * 2), lstb = mk_rsrc(F.LIST, (size_t)NEXP * T * 4), cwb = mk_rsrc(F.CW, (size_t)2 * T * 4);
    LAS unsigned char* lds = F.lds;
    LAS float* part = (LAS float*)(lds + RT_PART); LAS float* rstd_s = (LAS float*)(lds + RT_RSTD);
    LAS int* tok_e = (LAS int*)(lds + RT_TOKE); LAS float* tok_c = (LAS float*)(lds + RT_TOKC); LAS int* tok_p = (LAS int*)(lds + RT_TOKP);
    LAS int* lcnt = (LAS int*)(lds + RT_LCNT); LAS int* gbase = (LAS int*)(lds + RT_GBASE);
    const int w = F.wave;
    const float* gf = F.norm_ffn + (size_t)l * D;
    unsigned* cnt = R.cnt;
    for (int chunk = F.bid; chunk < T / 64; chunk += F.G) {
        int tid = F.tid; asm volatile("" : "+v"(tid));
        const int lane = tid & 63, r32 = lane & 31, hi = lane >> 5;
        __syncthreads();
        if (tid < 32) lcnt[tid] = 0;
        {
            v4u cu[4], nx[4];
            { const v4u* xr = (const v4u*)(F.X1B + (size_t)(chunk * 64 + w * 8) * D);
#pragma unroll
              for (int j = 0; j < 4; ++j) cu[j] = xr[j * 64 + lane]; }
#pragma unroll 1
            for (int i = 0; i < 8; ++i) {
                const int ti = w * 8 + i, t = chunk * 64 + ti;
                if (i < 7) { const v4u* xr = (const v4u*)(F.X1B + (size_t)(t + 1) * D);
#pragma unroll
                    for (int j = 0; j < 4; ++j) nx[j] = xr[j * 64 + lane]; }
                __builtin_amdgcn_sched_barrier(0);
                float xv[4][8];
#pragma unroll
                for (int j = 0; j < 4; ++j) unpack8(cu[j], xv[j]);
                float ss_ = 0.f;
#pragma unroll
                for (int j = 0; j < 4; ++j)
#pragma unroll
                    for (int e = 0; e < 8; ++e) ss_ += xv[j][e] * xv[j][e];
                const float rstd = 1.0f / sqrtf(wave_sum(ss_) * (1.0f / D) + EPS);
                if (lane == 0) { rstd_s[ti] = rstd; F.RS2[t] = rstd; }
#pragma unroll
                for (int j = 0; j < 4; ++j) cu[j] = nx[j];
            }
        }
        {
            const int tile = w >> 2, kq = w & 3;
            f32x16 a0, a1;
#pragma unroll
            for (int i = 0; i < 16; ++i) { a0[i] = 0.f; a1[i] = 0.f; }
            const bf16* xp = F.X1B + (size_t)(chunk * 64 + tile * 32 + r32) * D + kq * 512 + 8 * hi;
            const bf16* wh = F.WR_T + (size_t)(l * 2 + 0) * 64 * D + (size_t)kq * 32 * 512 + lane * 8;
            const bf16* wl = F.WR_T + (size_t)(l * 2 + 1) * 64 * D + (size_t)kq * 32 * 512 + lane * 8;
            bf16x8 fx[2][4], fh0[2][4], fl0[2][4], fh1[2][4], fl1[2][4];
#define RT_LOADB(bf, q) do { _Pragma("unroll") for (int i = 0; i < 4; ++i) { const int s_ = 4 * (q) + i; fx[bf][i] = *(const bf16x8*)(xp + 16 * s_); \
                fh0[bf][i] = *(const bf16x8*)(wh + 512 * s_); fl0[bf][i] = *(const bf16x8*)(wl + 512 * s_); fh1[bf][i] = *(const bf16x8*)(wh + 4 * 32 * 512 + 512 * s_); fl1[bf][i] = *(const bf16x8*)(wl + 4 * 32 * 512 + 512 * s_); } } while (0)
            RT_LOADB(0, 0);
            __builtin_amdgcn_sched_barrier(0);
#pragma unroll
            for (int q = 0; q < 8; ++q) {
                if (q < 7) { if (q & 1) RT_LOADB(0, q + 1); else RT_LOADB(1, q + 1); }
                __builtin_amdgcn_sched_barrier(0);
#pragma unroll
                for (int i = 0; i < 4; ++i) { const int bf = q & 1;
                    a0 = MFMA32(fh0[bf][i], fx[bf][i], a0); a0 = MFMA32(fl0[bf][i], fx[bf][i], a0);
                    a1 = MFMA32(fh1[bf][i], fx[bf][i], a1); a1 = MFMA32(fl1[bf][i], fx[bf][i], a1); }
                __builtin_amdgcn_sched_barrier(0);
            }
#undef RT_LOADB
#pragma unroll
            for (int i = 0; i < 16; ++i) { part[(w * 32 + i) * 64 + lane] = a0[i]; part[(w * 32 + 16 + i) * 64 + lane] = a1[i]; }
        }
        __syncthreads();
        if ((w & 3) == 0) {
            const int ti = (w >> 2) * 32 + r32;
            float e16[16], g4v[4];
#pragma unroll
            for (int i = 0; i < 16; ++i) e16[i] = ((part[((w + 0) * 32 + i) * 64 + lane] + part[((w + 1) * 32 + i) * 64 + lane]) + part[((w + 2) * 32 + i) * 64 + lane]) + part[((w + 3) * 32 + i) * 64 + lane];
#pragma unroll
            for (int i = 0; i < 4; ++i) g4v[i] = ((part[((w + 0) * 32 + 16 + i) * 64 + lane] + part[((w + 1) * 32 + 16 + i) * 64 + lane]) + part[((w + 2) * 32 + 16 + i) * 64 + lane]) + part[((w + 3) * 32 + 16 + i) * 64 + lane];
            const float rstd = rstd_s[ti];
            float lg[4];
#pragma unroll
            for (int q = 0; q < 4; ++q) lg[q] = __shfl(g4v[q], r32) * rstd + F.b_rg[l * 4 + q];
            int gi = 0; float gm = lg[0];
#pragma unroll
            for (int q = 1; q < 4; ++q) if (lg[q] > gm) { gm = lg[q]; gi = q; }
            float gs = 0.f;
#pragma unroll
            for (int q = 0; q < 4; ++q) gs += expf(lg[q] - gm);
            const float g_w = 1.0f / gs;
            float mine[4], theirs[4];
#pragma unroll
            for (int q = 0; q < 4; ++q) { float vsel = e16[q];
#pragma unroll
                for (int g2 = 1; g2 < 4; ++g2) vsel = (gi == g2) ? e16[4 * g2 + q] : vsel;
                mine[q] = vsel * rstd + F.b_re[l * NEXP + gi * 8 + 4 * hi + q]; theirs[q] = __shfl_xor(mine[q], 32); }
            float sel[8];
#pragma unroll
            for (int q = 0; q < 4; ++q) { sel[q] = hi ? theirs[q] : mine[q]; sel[4 + q] = hi ? mine[q] : theirs[q]; }
            int i0 = 0; float m0 = sel[0];
#pragma unroll
            for (int q = 1; q < 8; ++q) if (sel[q] > m0) { m0 = sel[q]; i0 = q; }
            int i1 = -1; float m1 = -INFINITY;
#pragma unroll
            for (int q = 0; q < 8; ++q) if (q != i0 && sel[q] > m1) { m1 = sel[q]; i1 = q; }
            const float w0 = 1.0f / (1.0f + expf(m1 - m0)), w1 = 1.0f - w0;
            if (hi == 0) { tok_e[ti * 2] = gi * 8 + i0; tok_e[ti * 2 + 1] = gi * 8 + i1; tok_c[ti * 2] = g_w * w0; tok_c[ti * 2 + 1] = g_w * w1; }
        }
        __syncthreads();
        if (tid < 128) tok_p[tid] = atomicAdd((int*)&lcnt[tok_e[tid]], 1);
        __syncthreads();
        if (tid < 32) gbase[tid] = (int)__hip_atomic_fetch_add(cnt + tid * 64, (unsigned)lcnt[tid], RLX_AGENT);
        __syncthreads();
        if (tid < 128) { const int e = tok_e[tid], slot = (chunk * 64 + (tid >> 1)) * 2 + (tid & 1);
            ST4(lstb, ((size_t)e * T + gbase[e] + tok_p[tid]) * 4, (unsigned)slot); ST4(cwb, (size_t)slot * 4, __builtin_bit_cast(unsigned, tok_c[tid])); }
    }
    __syncthreads();
}
#define CAS __attribute__((address_space(4)))
__device__ __forceinline__ void build_frame(Frame& F, LAS unsigned char* lds) {
    const CAS Args* ka = (const CAS Args*)__builtin_amdgcn_kernarg_segment_ptr();
    asm volatile("" : "+s"(ka));
    F.lds = lds;
    int t_ = threadIdx.x; asm volatile("" : "+v"(t_));
    F.tid = t_; F.lane = F.tid & 63; F.wave = __builtin_amdgcn_readfirstlane(F.tid >> 6);
    { int g_ = gridDim.x, b_ = blockIdx.x; asm volatile("" : "+s"(g_), "+s"(b_)); F.G = g_; F.bid = b_; }
    unsigned char* ws = ka->ws;
    F.ctl = (gu32*)(ws + WS_CTL);
    F.x = (const float*)ka->in[0]; F.pos = (const int*)ka->in[1]; F.norm_mix = (const float*)ka->in[2]; F.w_in = (const float*)ka->in[3];
    F.w_pool = (const float*)ka->in[4]; F.pool_scale = (const float*)ka->in[5]; F.q_norm = (const float*)ka->in[6]; F.k_norm = (const float*)ka->in[7];
    F.sink = (const float*)ka->in[8]; F.g_pool = (const float*)ka->in[9]; F.g_attn = (const float*)ka->in[10]; F.w_out = (const float*)ka->in[11];
    F.norm_ffn = (const float*)ka->in[12]; F.w_rg = (const float*)ka->in[13]; F.b_rg = (const float*)ka->in[14]; F.w_re = (const float*)ka->in[15];
    F.b_re = (const float*)ka->in[16]; F.w_gate = (const float*)ka->in[17]; F.w_up = (const float*)ka->in[18]; F.w_down = (const float*)ka->in[19];
    F.out = ka->out;
    F.HB = (bf16*)(ws + WS_HB); F.Z = (bf16*)(ws + WS_Z); F.VT = (bf16*)(ws + WS_VT); F.MIX = (bf16*)(ws + WS_MIX); F.ABUF = (bf16*)(ws + WS_ABUF); F.Y = (bf16*)(ws + WS_Y);
    F.LIST = (int*)(ws + WS_LIST); F.CW = (float*)(ws + WS_CW);
    F.WIN_T = (bf16*)(ws + WS_WIN); F.WOUT_T = (bf16*)(ws + WS_WOUT); F.WGU_T = (bf16*)(ws + WS_WGU); F.WD_T = (bf16*)(ws + WS_WD); F.WP_T = (bf16*)(ws + WS_WPOOL); F.ROPE = (float*)(ws + WS_ROPE); F.WR_T = (bf16*)(ws + WS_WR); F.XRB = (bf16*)(ws + WS_XRB); F.X1B = (bf16*)(ws + WS_X1B); F.RS2 = (float*)(ws + WS_RS2); F.RS1 = (float*)(ws + WS_RS1);
}

#define LDS0 ((LAS unsigned char*)(unsigned)0u)
__global__ void __launch_bounds__(NTHREADS, 2) fwd(Args args) {
    extern __shared__ __attribute__((aligned(16))) unsigned char lds[];
    Frame F; build_frame(F, (LAS unsigned char*)lds);
    for (int u = F.tid; u < (LDS_BYTES - LDSCTL_OFF) / 4; u += NTHREADS) ((LAS unsigned*)(F.lds + LDSCTL_OFF))[u] = 0u;
    __syncthreads();
    if (START_DELAY_TICKS) { const unsigned long long t0_ = __builtin_amdgcn_s_memrealtime(); while (__builtin_amdgcn_s_memrealtime() - t0_ < START_DELAY_TICKS) __builtin_amdgcn_s_sleep(8); }
    const int lo = args.ph_lo, hi = args.ph_hi;
    const bool use_bar = (hi - lo) > 1;
    XcdBarrier bar; bar.bar = (unsigned*)(F.ctl + CW_BAR) + args.li * XCD_BAR_WORDS; bar.x = 0; bar.st = nullptr;
    if (use_bar) bar = xcd_barrier_post((unsigned*)(F.ctl + CW_BAR) + args.li * XCD_BAR_WORDS, (volatile LAS unsigned*)(LDS0 + MISC_OFF + 32));
#define IN(k) (lo <= (k) && (k) < hi)
#define SEAM(k) do { if (IN(k) && IN((k) + 1)) xcd_barrier(bar); } while (0)
    if (IN(0)) { build_frame(F, LDS0); p_prologue(F); SEAM(0); }
    for (int l = 0; l < DEPTH; ++l) {
        const int p0 = 1 + 7 * l;
        if (IN(p0 + 0)) { build_frame(F, LDS0); p_gemm1(F, l); SEAM(p0 + 0); }
        if (IN(p0 + 1)) { build_frame(F, LDS0); p_mix(F, l); SEAM(p0 + 1); }
        if (IN(p0 + 2)) { build_frame(F, LDS0); p_gemm2(F, l); SEAM(p0 + 2); }
        if (IN(p0 + 3)) { build_frame(F, LDS0); p_router(F, l); SEAM(p0 + 3); }
        if (IN(p0 + 4)) { build_frame(F, LDS0); p_moe_gu(F, l); SEAM(p0 + 4); }
        if (IN(p0 + 5)) { build_frame(F, LDS0); p_moe_dn(F, l); SEAM(p0 + 5); }
        if (IN(p0 + 6)) { build_frame(F, LDS0); p_combine(F, l); SEAM(p0 + 6); }
    }
#undef IN
#undef SEAM
}

extern "C" void kernel_launch(void* const* d_in, const int* in_sizes, int n_in, void* d_out, int out_size, void* d_ws, size_t ws_size, hipStream_t stream) {
    static int grid = 0;
    if (grid == 0) {
        if (n_in != 20 || in_sizes[0] != T * D || out_size != T * D || ws_size < WS_END) {
            fprintf(stderr, "kernel_launch: unexpected shapes: n_in %d in0 %d out %d ws %zu (need %zu)\n", n_in, n_in > 0 ? in_sizes[0] : -1, out_size, ws_size, (size_t)WS_END); grid = -1; return; }
        int dev = 0, cus = 0, per_cu = 0;
        if (hipGetDevice(&dev) != hipSuccess || hipDeviceGetAttribute(&cus, hipDeviceAttributeMultiprocessorCount, dev) != hipSuccess) { grid = -1; return; }
        if (hipFuncSetAttribute((const void*)fwd, hipFuncAttributeMaxDynamicSharedMemorySize, LDS_BYTES) != hipSuccess) { fprintf(stderr, "kernel_launch: hipFuncSetAttribute failed\n"); grid = -1; return; }
        if (hipOccupancyMaxActiveBlocksPerMultiprocessor(&per_cu, (const void*)fwd, NTHREADS, LDS_BYTES) != hipSuccess || per_cu < 1)
            fprintf(stderr, "kernel_launch: occupancy query reports %d blocks per CU\n", per_cu);
        (void)hipGetLastError();
        grid = cus;
    }
    if (grid < 0) return;
    if (hipMemsetAsync((char*)d_ws + WS_CTL, 0, CTL_ZERO_BYTES, stream) != hipSuccess) { fprintf(stderr, "kernel_launch: memset failed\n"); return; }
    Args a{};
    for (int i = 0; i < 20; ++i) a.in[i] = d_in[i];
    a.out = (float*)d_out; a.ws = (unsigned char*)d_ws; a.pad = 0;
#if MK_ONE_LAUNCH
    a.ph_lo = 0; a.ph_hi = NPH; a.li = 0;
    hipLaunchKernelGGL(fwd, dim3(grid), dim3(NTHREADS), LDS_BYTES, stream, a);
#else
    for (int p = 0; p < NPH; ++p) { a.ph_lo = p; a.ph_hi = p + 1; a.li = 0; hipLaunchKernelGGL(fwd, dim3(grid), dim3(NTHREADS), LDS_BYTES, stream, a); }
#endif
    const hipError_t le = hipPeekAtLastError();
    if (le != hipSuccess) fprintf(stderr, "kernel_launch: launch failed: %s\n", hipGetErrorName(le));
}
```

```cpp
#include <hip/hip_runtime.h>
#include <cstdio>
#include <cstdint>

#ifndef BAR_DELAY_TICKS
#define BAR_DELAY_TICKS 0ull
#endif
#ifndef START_DELAY_TICKS
#define START_DELAY_TICKS 0ull
#endif
#ifndef MK_ONE_LAUNCH
#define MK_ONE_LAUNCH 1
#endif

constexpr int D = 2048, BATCH = 8, SEQ = 2048, T = BATCH * SEQ, DEPTH = 2;
constexpr int POOLW = 1024, ATTW = 1024, KVW = 256, NIN = 2560, HD = 128, NQH = 8;
constexpr int NEXP = 32, EPG = 8, DEXP = 512;
constexpr float EPS = 1e-6f;
constexpr int NWAVES = 8, NTHREADS = 512;
constexpr int NPH = 1 + 7 * DEPTH;

constexpr size_t MiB = 1u << 20;
constexpr size_t WS_CTL = 0, CTL_ZERO_BYTES = 1 * MiB;
constexpr size_t WS_HB = 2 * MiB;
constexpr size_t WS_Z = WS_HB + 64 * MiB;
constexpr size_t WS_VT = WS_Z + 80 * MiB;
constexpr size_t WS_MIX = WS_VT + 8 * MiB;
constexpr size_t WS_ABUF = WS_MIX + 64 * MiB;
constexpr size_t WS_Y = WS_ABUF + 40 * MiB;
constexpr size_t WS_LIST = WS_Y + 128 * MiB;
constexpr size_t WS_CW = WS_LIST + 2 * MiB;
constexpr size_t WS_WIN = WS_CW + 1 * MiB;
constexpr size_t WS_WOUT = WS_WIN + 20 * MiB;
constexpr size_t WS_WGU = WS_WOUT + 16 * MiB;
constexpr size_t WS_WD = WS_WGU + 256 * MiB;
constexpr size_t WS_WPOOL = WS_WD + 128 * MiB;
constexpr size_t WS_ROPE = WS_WPOOL + 1 * MiB;
constexpr size_t WS_WR = WS_ROPE + 2 * MiB;
constexpr size_t WS_XRB = WS_WR + 1 * MiB;
constexpr size_t WS_X1B = WS_XRB + 64 * MiB;
constexpr size_t WS_RS2 = WS_X1B + 64 * MiB;
constexpr size_t WS_RS1 = WS_RS2 + 1 * MiB;
constexpr size_t WS_END = WS_RS1 + 1 * MiB;
constexpr int CW_TMO = 0, CW_CODE = 1;
constexpr int CW_BAR = 4096;
constexpr int CW_CNT = 131072;

constexpr int RING_BYTES = 131072;
constexpr int LDSCTL_OFF = RING_BYTES, MISC_OFF = LDSCTL_OFF + 320;
constexpr int LDS_BYTES = 147456;
constexpr int CNT_OFF = LDSCTL_OFF + 512, BASE_OFF = LDSCTL_OFF + 640, USTART_OFF = LDSCTL_OFF + 768;

#define GAS __attribute__((address_space(1)))
#define LAS __attribute__((address_space(3)))
typedef unsigned short bf16;
typedef unsigned v4u __attribute__((ext_vector_type(4)));
typedef unsigned v2u __attribute__((ext_vector_type(2)));
typedef float f32x4 __attribute__((ext_vector_type(4)));
typedef float f32x16 __attribute__((ext_vector_type(16)));
typedef short bf16x8 __attribute__((ext_vector_type(8)));
typedef GAS unsigned gu32;
#define RLX_AGENT __ATOMIC_RELAXED, __HIP_MEMORY_SCOPE_AGENT
typedef __amdgpu_buffer_rsrc_t rsrc_t;
__device__ __forceinline__ rsrc_t mk_rsrc(const void* base, size_t bytes) { return __builtin_amdgcn_make_buffer_rsrc((void*)base, 0, (int)bytes, 0x00020000); }
#define ST16(r, off, v) __builtin_amdgcn_raw_buffer_store_b128((v), (r), (int)(off), 0, ST_AUX)
#ifndef ST_AUX
#define ST_AUX 0
#endif
#define ST4(r, off, v)  __builtin_amdgcn_raw_buffer_store_b32((v), (r), (int)(off), 0, ST_AUX)
#define ST2(r, off, v)  __builtin_amdgcn_raw_buffer_store_b16((v), (r), (int)(off), 0, ST_AUX)

__device__ __forceinline__ unsigned f2bf(float f) { unsigned u = __builtin_bit_cast(unsigned, f); return (u + 0x7fffu + ((u >> 16) & 1u)) >> 16; }
__device__ __forceinline__ unsigned pk2(float lo, float hi) { return f2bf(lo) | (f2bf(hi) << 16); }
__device__ __forceinline__ float bflo(unsigned u) { return __builtin_bit_cast(float, u << 16); }
__device__ __forceinline__ float bfhi(unsigned u) { return __builtin_bit_cast(float, u & 0xffff0000u); }
__device__ __forceinline__ float bf2f(bf16 b) { return __builtin_bit_cast(float, (unsigned)b << 16); }
__device__ __forceinline__ float wave_sum(float v) {
#pragma unroll
    for (int o = 1; o < 64; o <<= 1) v += __shfl_xor(v, o);
    return v;
}

#define XB_TMO      128
#define XB_XCNT(j)  (256  + 64 * (j))
#define XB_XSUB(j)  (1280 + 64 * (j))
#define XB_XGEN(j)  (2304 + 64 * (j))
#define XB_TOP      3328
#define XB_TOPGEN   3392
#define XCD_BAR_WORDS 3456
#define XB_SPIN_CAP (1u << 18)

__device__ __forceinline__ unsigned xb_ld(unsigned* p)              { return __hip_atomic_load(p, __ATOMIC_RELAXED, __HIP_MEMORY_SCOPE_AGENT); }
__device__ __forceinline__ unsigned xb_add(unsigned* p, unsigned v) { return __hip_atomic_fetch_add(p, v, __ATOMIC_RELAXED, __HIP_MEMORY_SCOPE_AGENT); }
__device__ __forceinline__ unsigned xb_xcc_id() { return (unsigned)__builtin_amdgcn_s_getreg((3 << 11) | 20) & 0xFu; }
#define XB_SPIN(cond, bar) do { unsigned _sp = 0; while (cond) { __builtin_amdgcn_s_sleep(1); \
    if ((++_sp & 255u) == 0u) { if (xb_ld(&(bar)[XB_TMO])) break; if (_sp > XB_SPIN_CAP) { atomicAdd(&(bar)[XB_TMO], 1u); break; } } } } while (0)

struct XcdBarrier {
    unsigned* bar; unsigned x;
    volatile LAS unsigned* st;
};
__device__ __forceinline__ XcdBarrier xcd_barrier_post(unsigned* bar, volatile LAS unsigned* st) {
    XcdBarrier b; b.bar = bar; b.x = xb_xcc_id(); b.st = st;
    if (threadIdx.x == 0) (void)xb_add(&bar[XB_XCNT(b.x)], 1u);
    return b;
}
__device__ __forceinline__ void xcd_barrier_complete(unsigned* bar, unsigned x, unsigned& nloc, unsigned& nx) {
    const unsigned G = gridDim.x * gridDim.y * gridDim.z;
    unsigned sum, cnt, mine, sp = 0u;
    for (;;) {
        sum = 0u; cnt = 0u; mine = 0u;
#pragma unroll
        for (unsigned j = 0; j < 16; ++j) { const unsigned c = xb_ld(&bar[XB_XCNT(j)]); sum += c; cnt += (c > 0u) ? 1u : 0u; mine = (j == x) ? c : mine; }
        if (sum == G) break;
        __builtin_amdgcn_s_sleep(1);
        if ((++sp & 255u) == 0u) { if (xb_ld(&bar[XB_TMO])) break; if (sp > XB_SPIN_CAP) { atomicAdd(&bar[XB_TMO], 1u); break; } }
    }
    nloc = mine > 0u ? mine : 1u; nx = cnt > 0u ? cnt : 1u;
}
__device__ __forceinline__ void xcd_barrier(const XcdBarrier& b) {
    asm volatile("s_waitcnt vmcnt(0)" ::: "memory");
    __syncthreads();
    int t0_ = threadIdx.x; asm volatile("" : "+v"(t0_));
    if (t0_ == 0) {
        unsigned* bar = b.bar;
        __builtin_amdgcn_s_waitcnt(0);
        unsigned nloc = b.st[0], nx = b.st[1];
        if (nloc == 0u) { xcd_barrier_complete(bar, b.x, nloc, nx); b.st[0] = nloc; b.st[1] = nx; }
        const unsigned old = xb_add(&bar[XB_XSUB(b.x)], 1u);
        const unsigned gen = old / nloc;
        if (old + 1u == (gen + 1u) * nloc) {
            __builtin_amdgcn_fence(__ATOMIC_RELEASE, "agent");
            asm volatile("s_waitcnt vmcnt(0)" ::: "memory");
            const unsigned og = xb_add(&bar[XB_TOP], 1u);
            const unsigned tg = og / nx;
            if (og + 1u == (tg + 1u) * nx) xb_add(&bar[XB_TOPGEN], 1u);
            else XB_SPIN(xb_ld(&bar[XB_TOPGEN]) == tg, bar);
            __builtin_amdgcn_fence(__ATOMIC_ACQUIRE, "agent");
            xb_add(&bar[XB_XGEN(b.x)], 1u);
            asm volatile("s_waitcnt vmcnt(0)" ::: "memory");
        } else {
            XB_SPIN(xb_ld(&bar[XB_XGEN(b.x)]) == gen, bar);
            __builtin_amdgcn_fence(__ATOMIC_ACQUIRE, "agent");
            asm volatile("s_waitcnt vmcnt(0)" ::: "memory");
        }
    }
#if BAR_DELAY_TICKS
    if (threadIdx.x == 0) { const unsigned long long t0_ = __builtin_amdgcn_s_memrealtime(); while (__builtin_amdgcn_s_memrealtime() - t0_ < BAR_DELAY_TICKS) __builtin_amdgcn_s_sleep(2); }
#endif
    __syncthreads();
}
struct Args { const void* in[20]; float* out; unsigned char* ws; int ph_lo, ph_hi, li, pad; };

struct Frame {
    LAS unsigned char* lds;
    gu32* ctl;
    int tid, lane, wave, G, bid;
    const float* x; const int* pos;
    const float *norm_mix, *w_in, *w_pool, *pool_scale, *q_norm, *k_norm, *sink, *g_pool, *g_attn, *w_out, *norm_ffn, *w_rg, *b_rg, *w_re, *b_re, *w_gate, *w_up, *w_down;
    float* out;
    bf16 *HB, *Z, *VT, *MIX, *ABUF, *Y;
    int* LIST; float* CW;
    bf16 *WIN_T, *WOUT_T, *WGU_T, *WD_T, *WP_T, *WR_T, *XRB, *X1B; float* ROPE; float* RS2; float* RS1;
};

#define MFMA32(a, b, c) __builtin_amdgcn_mfma_f32_32x32x16_bf16((a), (b), (c), 0, 0, 0)
__device__ __forceinline__ int crow(int reg, int h) { return (reg & 3) + 8 * (reg >> 2) + 4 * h; }

__device__ __forceinline__ void unpack8(const v4u p, float (&x)[8]) { x[0] = bflo(p.x); x[1] = bfhi(p.x); x[2] = bflo(p.y); x[3] = bfhi(p.y); x[4] = bflo(p.z); x[5] = bfhi(p.z); x[6] = bflo(p.w); x[7] = bfhi(p.w); }
__device__ __forceinline__ v4u pack8(const float (&x)[8]) { v4u w; w.x = pk2(x[0], x[1]); w.y = pk2(x[2], x[3]); w.z = pk2(x[4], x[5]); w.w = pk2(x[6], x[7]); return w; }
__device__ __forceinline__ void norm_gains(const float* g, int lane, f32x4 (&gg)[8]) {
    const f32x4* gr = (const f32x4*)g;
#pragma unroll
    for (int j = 0; j < 4; ++j) { gg[2 * j] = gr[(j * 64 + lane) * 2]; gg[2 * j + 1] = gr[(j * 64 + lane) * 2 + 1]; }
}
__device__ __forceinline__ float norm_store(const float (&xv)[4][8], const f32x4 (&gg)[8], rsrc_t ob, size_t obyte, int lane) {
    float s = 0.f;
#pragma unroll
    for (int j = 0; j < 4; ++j)
#pragma unroll
        for (int e = 0; e < 8; ++e) s += xv[j][e] * xv[j][e];
    const float rstd = 1.0f / sqrtf(wave_sum(s) * (1.0f / D) + EPS);
#pragma unroll
    for (int j = 0; j < 4; ++j) { const f32x4 g0 = gg[2 * j], g1 = gg[2 * j + 1];
        const float y[8] = {xv[j][0] * rstd * g0.x, xv[j][1] * rstd * g0.y, xv[j][2] * rstd * g0.z, xv[j][3] * rstd * g0.w, xv[j][4] * rstd * g1.x, xv[j][5] * rstd * g1.y, xv[j][6] * rstd * g1.z, xv[j][7] * rstd * g1.w};
        ST16(ob, obyte + (size_t)(j * 64 + lane) * 16, pack8(y)); }
    return rstd;
}

__device__ __forceinline__ float row_rstd(const float (&xv)[4][8]) {
    float s = 0.f;
#pragma unroll
    for (int j = 0; j < 4; ++j)
#pragma unroll
        for (int e = 0; e < 8; ++e) s += xv[j][e] * xv[j][e];
    return 1.0f / sqrtf(wave_sum(s) * (1.0f / D) + EPS);
}
__device__ __forceinline__ void p_prologue_rows(Frame& F) {
    const int gw = F.bid * NWAVES + F.wave, NGW = F.G * NWAVES, lane = F.lane;
    const rsrc_t hb = mk_rsrc(F.HB, (size_t)T * D * 2), xb = mk_rsrc(F.XRB, (size_t)T * D * 2);
    f32x4 cu[8], nx[8];
    if (gw < T) { const f32x4* xr = (const f32x4*)(F.x + (size_t)gw * D);
#pragma unroll
        for (int j = 0; j < 4; ++j) { cu[2 * j] = xr[(j * 64 + lane) * 2]; cu[2 * j + 1] = xr[(j * 64 + lane) * 2 + 1]; } }
    for (int m = gw; m < T; m += NGW) {
        if (m + NGW < T) { const f32x4* xr = (const f32x4*)(F.x + (size_t)(m + NGW) * D);
#pragma unroll
            for (int j = 0; j < 4; ++j) { nx[2 * j] = xr[(j * 64 + lane) * 2]; nx[2 * j + 1] = xr[(j * 64 + lane) * 2 + 1]; } }
        __builtin_amdgcn_sched_barrier(0);
        float xv[4][8];
#pragma unroll
        for (int j = 0; j < 4; ++j) { const f32x4 a = cu[2 * j], c = cu[2 * j + 1]; xv[j][0] = a.x; xv[j][1] = a.y; xv[j][2] = a.z; xv[j][3] = a.w; xv[j][4] = c.x; xv[j][5] = c.y; xv[j][6] = c.z; xv[j][7] = c.w; }
#pragma unroll
        for (int j = 0; j < 4; ++j) ST16(xb, (size_t)m * D * 2 + (size_t)(j * 64 + lane) * 16, pack8(xv[j]));
        { const float rs_ = row_rstd(xv); if (lane == 0) F.RS1[m] = rs_; }
#pragma unroll
        for (int j = 0; j < 8; ++j) cu[j] = nx[j];
    }
}

struct RtOut { int* LIST; float* CW; unsigned* cnt; int* EID; };
__device__ __forceinline__ void load_counts(Frame& F, int l, int nN) {
    LAS int* cnt_s = (LAS int*)(F.lds + CNT_OFF); LAS int* base_s = (LAS int*)(F.lds + BASE_OFF); LAS int* ustart = (LAS int*)(F.lds + USTART_OFF);
    __syncthreads();
    if (F.tid < 32) cnt_s[F.tid] = (int)__hip_atomic_load((unsigned*)(F.ctl + CW_CNT) + (l * 32 + F.tid) * 64, RLX_AGENT);
    __syncthreads();
    if (F.tid == 0) { int b = 0, us = 0; for (int e = 0; e < 32; ++e) { base_s[e] = b; ustart[e] = us; b += (cnt_s[e] + 255) & ~255; us += ((cnt_s[e] + 255) >> 8) * nN; } ustart[32] = us; }
    __syncthreads();
}

__device__ __forceinline__ void p_combine(Frame& F, int l) {
    const int gw = F.bid * NWAVES + F.wave, NGW = F.G * NWAVES; const int lane = F.lane;
    const rsrc_t ob = mk_rsrc(F.out, (size_t)T * D * 4), xb = mk_rsrc(F.XRB, (size_t)T * D * 2), hb = mk_rsrc(F.HB, (size_t)T * D * 2);
    v4u a[4], p[4], q[4], an[4], pn[4], qn[4];
    if (gw < T) { const v4u* x1 = (const v4u*)(F.X1B + (size_t)gw * D); const v4u* y0 = (const v4u*)(F.Y + (size_t)(2 * gw) * D); const v4u* y1 = (const v4u*)(F.Y + (size_t)(2 * gw + 1) * D);
#pragma unroll
        for (int j = 0; j < 4; ++j) { const int c = j * 64 + lane; a[j] = x1[c]; p[j] = y0[c]; q[j] = y1[c]; } }
    for (int t = gw; t < T; t += NGW) {
        if (t + NGW < T) { const int tn = t + NGW; const v4u* x1 = (const v4u*)(F.X1B + (size_t)tn * D); const v4u* y0 = (const v4u*)(F.Y + (size_t)(2 * tn) * D); const v4u* y1 = (const v4u*)(F.Y + (size_t)(2 * tn + 1) * D);
#pragma unroll
            for (int j = 0; j < 4; ++j) { const int c = j * 64 + lane; an[j] = x1[c]; pn[j] = y0[c]; qn[j] = y1[c]; } }
        __builtin_amdgcn_sched_barrier(0);
        float xv[4][8];
#pragma unroll
        for (int j = 0; j < 4; ++j) { float u[8], v[8], w[8]; unpack8(a[j], u); unpack8(p[j], v); unpack8(q[j], w);
#pragma unroll
            for (int e = 0; e < 8; ++e) xv[j][e] = u[e] + v[e] + w[e]; }
        if (l + 1 < DEPTH) {
#pragma unroll
            for (int j = 0; j < 4; ++j) ST16(xb, (size_t)t * D * 2 + (size_t)(j * 64 + lane) * 16, pack8(xv[j]));
            { const float rs_ = row_rstd(xv); if (lane == 0) F.RS1[t] = rs_; }
        } else {
#pragma unroll
            for (int j = 0; j < 4; ++j) { const int c = j * 64 + lane; const f32x4 o0 = {xv[j][0], xv[j][1], xv[j][2], xv[j][3]}, o1 = {xv[j][4], xv[j][5], xv[j][6], xv[j][7]};
                ST16(ob, ((size_t)t * D + 8 * c) * 4, __builtin_bit_cast(v4u, o0)); ST16(ob, ((size_t)t * D + 8 * c + 4) * 4, __builtin_bit_cast(v4u, o1)); }
        }
#pragma unroll
        for (int j = 0; j < 4; ++j) { a[j] = an[j]; p[j] = pn[j]; q[j] = qn[j]; }
    }
}

namespace pg8 {
typedef unsigned u32x4 __attribute__((ext_vector_type(4)));
constexpr int BM = 256, BK = 64, HALF = 128, HTB = HALF * BK * 2, STAGE_BYTES = 8 * HTB, NXCD = 8, WGM = 8;
__host__ __device__ __forceinline__ int lds_byte(int r, int c) { const int st = (r >> 4) * 2 + (c >> 5), rr = r & 15, cc = c & 31, ob = rr * 64 + cc * 2; return st * 1024 + (ob ^ (((ob >> 9) & 1) << 5)); }
__host__ __device__ __forceinline__ void stage_rc(int b, int& R, int& C) { const int st = b / 1024, sb = b % 1024, swz = sb ^ (((sb >> 9) & 1) << 5); R = (st >> 1) * 16 + swz / 64; C = (st & 1) * 32 + (swz % 64) / 2; }
__host__ __device__ __forceinline__ int perm32(int rho) { const int n = rho >> 4, i = rho & 15; return 8 * (i >> 2) + 4 * n + (i & 3); }

struct Unit { const char* a; const char* b; int pm, pn, e, rows, rbase, half; };

__device__ __forceinline__ int xcd_remap(int L, int nwg) { const int q = nwg / NXCD, r = nwg % NXCD, xcd = L % NXCD, off = L / NXCD; return (xcd < r ? xcd * (q + 1) : r * (q + 1) + (xcd - r) * q) + off; }

struct DenseOrder {
    int nM, nN, nwg, G, c, K; const char* A; const char* Bt;
    __device__ __forceinline__ void init(const bf16* A_, const bf16* Bt_, int M, int N, int K_, int G_, int c_) { A = (const char*)A_; Bt = (const char*)Bt_; nM = M / BM; nN = N / BM; nwg = nM * nN; G = G_; c = c_; K = K_; }
    __device__ __forceinline__ bool next(int i, Unit& u) const {
        int L = i * G + c, half = -1;
        if (G == 256 && nwg == 640 && i == 2) { L = 512 + (c & 127); half = c >> 7; }
        if (L >= nwg) return false;
        u.half = half;
        const int wgid = xcd_remap(L, nwg);
        const int nig = WGM * nN, gid = wgid / nig, fm = gid * WGM, gsz = (nM - fm) < WGM ? (nM - fm) : WGM;
        u.pm = fm + ((wgid % nig) % gsz); u.pn = (wgid % nig) / gsz; u.e = 0; u.rows = BM; u.rbase = u.pm * BM;
        u.a = A + (size_t)u.pm * BM * K * 2; u.b = Bt + (size_t)u.pn * BM * K * 2; return true;
    }
    __device__ __forceinline__ unsigned gather_off(const Unit&, int) const { return 0u; }
};
struct MoeOrder {
    const LAS int* cnt_s; const LAS int* base_s; const LAS int* ustart; int nN, G, c, K, total, gather; const char* A; const char* Bt; size_t b_estride; const int* LIST;
    __device__ __forceinline__ bool next(int i, Unit& u) const {
        int L = i * G + c, half = -1;
        if (!gather && G == 256 && i == 4 && total > 1024 && total <= 1152) { L = 1024 + (c & 127); half = c >> 7; }
        if (L >= total) return false;
        const int wgid = xcd_remap(L, total);
        const int lane_ = (int)(threadIdx.x & 31u);
        const unsigned long long msk = __ballot(wgid < ustart[lane_ + 1]);
        int e = __builtin_ctzll(msk | (1ull << 31)) & 31;
        e = __builtin_amdgcn_readfirstlane(e);
        const int loc = wgid - __builtin_amdgcn_readfirstlane(ustart[e]), cnt = __builtin_amdgcn_readfirstlane(cnt_s[e]), mtl = (cnt + 255) >> 8, mt = loc % mtl, pn = loc / mtl;
        u.half = half; u.e = e; u.pm = mt; u.pn = pn; u.rows = (cnt - mt * BM) < BM ? (cnt - mt * BM) : BM; u.rbase = __builtin_amdgcn_readfirstlane(base_s[e]) + mt * BM;
        u.b = Bt + (size_t)e * b_estride + (size_t)pn * BM * K * 2;
        u.a = gather ? A : A + (size_t)u.rbase * K * 2;
        return true;
    }
    __device__ __forceinline__ unsigned gather_off(const Unit& u, int r) const { const int rr = r < u.rows ? r : u.rows - 1; return (unsigned)(LIST[(size_t)u.e * T + u.pm * BM + rr] >> 1) * (unsigned)(K * 2); }
};

__device__ __forceinline__ unsigned cvt_pk_bf16(float lo, float hi) { unsigned r; asm volatile("v_cvt_pk_bf16_f32 %0, %1, %2" : "=v"(r) : "v"(lo), "v"(hi)); return r; }

struct EpiZ {
    static constexpr bool PERM = true;
    rsrc_t Z; rsrc_t VT; int l;
    __device__ __forceinline__ void kprep(const f32x4 (&acc)[2][2][4][2], const Unit& u, int wr_, int wc_, int fr_, int fq_) const {
        int fr = fr_, fq = fq_; asm volatile("" : "+v"(fr), "+v"(fq));
        const int wr = wr_, wc = wc_;
        const int row0 = u.rbase + wr * 64 + fr, col0 = u.pn * BM + wc * 32 + 8 * fq;
            const __attribute__((address_space(4))) Args* ka_ = (const __attribute__((address_space(4))) Args*)__builtin_amdgcn_kernarg_segment_ptr();
            const float* kg = (const float*)ka_->in[7] + l * HD; const float* rope = (const float*)(ka_->ws + WS_ROPE); LAS float* red = (LAS float*)(unsigned)(LDSCTL_OFF + 2048);
            const float* rs1 = (const float*)(ka_->ws + WS_RS1);
            float rsv[2][4];
#pragma unroll
            for (int ai = 0; ai < 2; ++ai)
#pragma unroll
                for (int m = 0; m < 4; ++m) rsv[ai][m] = rs1[row0 + ai * HALF + m * 16];
#pragma unroll
            for (int ai = 0; ai < 2; ++ai)
#pragma unroll
                for (int m = 0; m < 4; ++m)
#pragma unroll
                    for (int bj = 0; bj < 2; ++bj) { if (u.half >= 0 && ai != u.half) continue; const f32x4 v0 = acc[ai][bj][m][0], v1 = acc[ai][bj][m][1];
                        float q = v0[0] * v0[0] + v0[1] * v0[1] + v0[2] * v0[2] + v0[3] * v0[3] + v1[0] * v1[0] + v1[1] * v1[1] + v1[2] * v1[2] + v1[3] * v1[3];
                        q *= rsv[ai][m] * rsv[ai][m];
                        q += __shfl_xor(q, 16); q += __shfl_xor(q, 32);
                        if (fq == 0) red[(bj * 256 + ai * HALF + wr * 64 + m * 16 + fr) * 4 + wc] = q; }
            asm volatile("s_waitcnt lgkmcnt(0)" ::: "memory"); __builtin_amdgcn_s_barrier(); asm volatile("" ::: "memory");
            const f32x4 g0 = *(const f32x4*)(kg + wc * 32 + 8 * fq), g1 = *(const f32x4*)(kg + wc * 32 + 8 * fq + 4);
#pragma unroll
            for (int ai = 0; ai < 2; ++ai)
#pragma unroll
                for (int m = 0; m < 4; ++m) { if (u.half >= 0 && ai != u.half) continue; const int r = row0 + ai * HALF + m * 16; const size_t ro = ((size_t)r * NIN + col0) * 2;
                    f32x4 c0 = {1.f, 1.f, 1.f, 1.f}, c1 = c0, s0 = {0.f, 0.f, 0.f, 0.f}, s1 = s0;
                    if (wc == 0) { const float* rp = rope + (size_t)r * 32 + 8 * (fq & 1); c0 = *(const f32x4*)rp; c1 = *(const f32x4*)(rp + 4); s0 = *(const f32x4*)(rp + 16); s1 = *(const f32x4*)(rp + 20); }
#pragma unroll
                    for (int bj = 0; bj < 2; ++bj) {
                        const f32x4 t4 = *(const LAS f32x4*)(red + (bj * 256 + ai * HALF + wr * 64 + m * 16 + fr) * 4);
                        const float rstd = 1.0f / sqrtf(((t4[0] + t4[1]) + (t4[2] + t4[3])) * (1.0f / 128.0f) + 1e-6f);
                        f32x4 v0 = acc[ai][bj][m][0] * (rstd * rsv[ai][m]) * g0, v1 = acc[ai][bj][m][1] * (rstd * rsv[ai][m]) * g1;
                        if (wc == 0) {
#pragma unroll
                            for (int e = 0; e < 4; ++e) { const float p0 = __shfl_xor(v0[e], 32), p1 = __shfl_xor(v1[e], 32);
                                v0[e] = (fq < 2) ? v0[e] * c0[e] - p0 * s0[e] : v0[e] * c0[e] + p0 * s0[e];
                                v1[e] = (fq < 2) ? v1[e] * c1[e] - p1 * s1[e] : v1[e] * c1[e] + p1 * s1[e]; } }
                        u32x4 w; w.x = cvt_pk_bf16(v0[0], v0[1]); w.y = cvt_pk_bf16(v0[2], v0[3]); w.z = cvt_pk_bf16(v1[0], v1[1]); w.w = cvt_pk_bf16(v1[2], v1[3]);
                        ST16(Z, ro + bj * HALF * 2, w); }
                    __builtin_amdgcn_sched_barrier(0); }
            asm volatile("s_waitcnt lgkmcnt(0)" ::: "memory"); __builtin_amdgcn_s_barrier(); asm volatile("" ::: "memory");
    }
    __device__ __forceinline__ void operator()(const f32x4 (&acc)[2][2][4][2], const Unit& u, int wr, int wc, int fr, int fq) const {
        if (u.pn == 8) { kprep(acc, u, wr, wc, fr, fq); return; }
        const int row0 = u.rbase + wr * 64 + fr, col0 = u.pn * BM + wc * 32 + 8 * fq;
        const float* rs1 = (const float*)(((const __attribute__((address_space(4))) Args*)__builtin_amdgcn_kernarg_segment_ptr())->ws + WS_RS1);
        float rsv[2][4];
#pragma unroll
        for (int ai = 0; ai < 2; ++ai)
#pragma unroll
            for (int m = 0; m < 4; ++m) rsv[ai][m] = rs1[row0 + ai * HALF + m * 16];
        __builtin_amdgcn_sched_barrier(0);
#pragma unroll
        for (int ai = 0; ai < 2; ++ai)
#pragma unroll
            for (int m = 0; m < 4; ++m) { if (u.half >= 0 && ai != u.half) continue; const size_t ro = ((size_t)(row0 + ai * HALF + m * 16) * NIN + col0) * 2;
#pragma unroll
                for (int bj = 0; bj < 2; ++bj) { const f32x4 v0 = acc[ai][bj][m][0] * rsv[ai][m], v1 = acc[ai][bj][m][1] * rsv[ai][m];
                    u32x4 w; w.x = cvt_pk_bf16(v0[0], v0[1]); w.y = cvt_pk_bf16(v0[2], v0[3]); w.z = cvt_pk_bf16(v1[0], v1[1]); w.w = cvt_pk_bf16(v1[2], v1[3]);
                    ST16(Z, ro + bj * HALF * 2, w); } }
        if (u.pn == 9) {
#pragma unroll
            for (int ai = 0; ai < 2; ++ai)
#pragma unroll
                for (int m = 0; m < 4; ++m) { if (u.half >= 0 && ai != u.half) continue; const int r = row0 + ai * HALF + m * 16, b = r >> 11, s = r & (SEQ - 1);
#pragma unroll
                    for (int bj = 0; bj < 2; ++bj)
#pragma unroll
                        for (int n = 0; n < 2; ++n)
#pragma unroll
                            for (int e = 0; e < 4; ++e) ST2(VT, (((size_t)((b * 2 + bj) * HD + wc * 32 + 8 * fq + 4 * n + e)) * SEQ + s) * 2, (short)f2bf(acc[ai][bj][m][n][e] * rsv[ai][m])); }
        }
    }
};
struct EpiRes {
    static constexpr bool PERM = true;
    const bf16* base; rsrc_t out;
    __device__ __forceinline__ void operator()(const f32x4 (&acc)[2][2][4][2], const Unit& u, int wr, int wc, int fr, int fq) const {
        const int row0 = u.rbase + wr * 64 + fr, col0 = u.pn * BM + wc * 32 + 8 * fq;
        u32x4 bvs[2][4][2];
#pragma unroll
        for (int ai = 0; ai < 2; ++ai)
#pragma unroll
            for (int m = 0; m < 4; ++m)
#pragma unroll
                for (int bj = 0; bj < 2; ++bj) bvs[ai][m][bj] = *(const u32x4*)(base + (size_t)(row0 + ai * HALF + m * 16) * D + col0 + bj * HALF);
        __builtin_amdgcn_sched_barrier(0);
#pragma unroll
        for (int ai = 0; ai < 2; ++ai)
#pragma unroll
            for (int m = 0; m < 4; ++m) { const size_t off = (size_t)(row0 + ai * HALF + m * 16) * D + col0;
#pragma unroll
                for (int bj = 0; bj < 2; ++bj) { const u32x4 bv = bvs[ai][m][bj]; const f32x4 v0 = acc[ai][bj][m][0], v1 = acc[ai][bj][m][1];
                    u32x4 w; w.x = cvt_pk_bf16(v0[0] + bflo(bv.x), v0[1] + bfhi(bv.x)); w.y = cvt_pk_bf16(v0[2] + bflo(bv.y), v0[3] + bfhi(bv.y)); w.z = cvt_pk_bf16(v1[0] + bflo(bv.z), v1[1] + bfhi(bv.z)); w.w = cvt_pk_bf16(v1[2] + bflo(bv.w), v1[3] + bfhi(bv.w));
                    ST16(out, (off + bj * HALF) * 2, w); } }
    }
};
struct EpiSilu {
    static constexpr bool PERM = true;
    rsrc_t ABUF; const int* LIST; const float* RS;
    __device__ __forceinline__ void operator()(const f32x4 (&acc)[2][2][4][2], const Unit& u, int wr, int wc, int fr, int fq) const {
        const int rl0 = wr * 64 + fr, col0 = u.pn * HALF + wc * 32 + 8 * fq;
        const int* lst = LIST + (size_t)u.e * T + u.pm * BM;
        int toks[2][4]; float rs[2][4];
#pragma unroll
        for (int ai = 0; ai < 2; ++ai)
#pragma unroll
            for (int m = 0; m < 4; ++m) { const int rl = rl0 + ai * HALF + m * 16; toks[ai][m] = lst[rl < u.rows ? rl : u.rows - 1] >> 1; }
        __builtin_amdgcn_sched_barrier(0);
#pragma unroll
        for (int ai = 0; ai < 2; ++ai)
#pragma unroll
            for (int m = 0; m < 4; ++m) rs[ai][m] = RS[toks[ai][m]];
        __builtin_amdgcn_sched_barrier(0);
#pragma unroll
        for (int ai = 0; ai < 2; ++ai)
#pragma unroll
            for (int m = 0; m < 4; ++m) { const int rl = rl0 + ai * HALF + m * 16;
                if (rl < u.rows) { float a[8]; const float r_ = rs[ai][m];
#pragma unroll
                    for (int n = 0; n < 2; ++n)
#pragma unroll
                        for (int e = 0; e < 4; ++e) { const float g = acc[ai][0][m][n][e] * r_, up = acc[ai][1][m][n][e] * r_;
                            a[n * 4 + e] = g * __builtin_amdgcn_rcpf(1.0f + __builtin_amdgcn_exp2f(-1.4426950408889634f * g)) * up; }
                    u32x4 w; w.x = cvt_pk_bf16(a[0], a[1]); w.y = cvt_pk_bf16(a[2], a[3]); w.z = cvt_pk_bf16(a[4], a[5]); w.w = cvt_pk_bf16(a[6], a[7]);
                    ST16(ABUF, ((size_t)(u.rbase + rl) * DEXP + col0) * 2, w); } }
    }
};
struct EpiScatter {
    static constexpr bool PERM = true;
    rsrc_t Y; const int* LIST; const float* CW;
    __device__ __forceinline__ void operator()(const f32x4 (&acc)[2][2][4][2], const Unit& u, int wr, int wc, int fr, int fq) const {
        const int rl0 = wr * 64 + fr, col0 = u.pn * BM + wc * 32 + 8 * fq;
        const int* lst = LIST + (size_t)u.e * T + u.pm * BM;
        int slots[2][4]; float cws[2][4];
#pragma unroll
        for (int ai = 0; ai < 2; ++ai)
#pragma unroll
            for (int m = 0; m < 4; ++m) { const int rl = rl0 + ai * HALF + m * 16; slots[ai][m] = lst[rl < u.rows ? rl : u.rows - 1]; }
        __builtin_amdgcn_sched_barrier(0);
#pragma unroll
        for (int ai = 0; ai < 2; ++ai)
#pragma unroll
            for (int m = 0; m < 4; ++m) cws[ai][m] = CW[slots[ai][m]];
        __builtin_amdgcn_sched_barrier(0);
#pragma unroll
        for (int ai = 0; ai < 2; ++ai)
#pragma unroll
            for (int m = 0; m < 4; ++m) { const int rl = rl0 + ai * HALF + m * 16;
                if (rl < u.rows && (u.half < 0 || ai == u.half)) { const int slot = slots[ai][m]; const float c = cws[ai][m]; const size_t ro = ((size_t)slot * D + col0) * 2;
#pragma unroll
                    for (int bj = 0; bj < 2; ++bj) { const f32x4 v0 = acc[ai][bj][m][0] * c, v1 = acc[ai][bj][m][1] * c;
                        u32x4 w; w.x = cvt_pk_bf16(v0[0], v0[1]); w.y = cvt_pk_bf16(v0[2], v0[3]); w.z = cvt_pk_bf16(v1[0], v1[1]); w.w = cvt_pk_bf16(v1[2], v1[3]);
                        ST16(Y, ro + bj * HALF * 2, w); } }
            }
    }
};

template <class Epi, class Sched, bool GATHER>
__device__ __forceinline__ void gemm_phase(LAS unsigned char* lds, const int tid, const int K, const Sched& S, const Epi& E) {
    const int wid = __builtin_amdgcn_readfirstlane(tid >> 6), lane = tid & 63, wr = wid >> 2, wc = wid & 3, fr = lane & 15, fq = lane >> 4;
    const int nt = K / BK;
    unsigned voffB[2];
#pragma unroll
    for (int i = 0; i < 2; ++i) { int R, C; stage_rc(tid * 16 + i * 8192, R, C); const int Rb = Epi::PERM ? ((R & ~31) + perm32(R & 31)) : R; voffB[i] = (unsigned)(Rb * K + C) * 2u; }
    const size_t kstep = (size_t)(BK * 2);
    const size_t hstepB = (size_t)HALF * K * 2;
    const unsigned ldsw = (unsigned)wid * 1024u;
    const int aoff = lds_byte(wr * 64 + fr, fq * 8), boff = lds_byte(wc * 32 + fr, fq * 8);
#define PG8_SA(b, h) (((b) * 2 + (h)) * HTB)
#define PG8_SB(b, h) ((4 + (b) * 2 + (h)) * HTB)
#define PG8_STAGE_B(bufoff, gbase) do { _Pragma("unroll") for (int _i = 0; _i < 2; ++_i) \
        __builtin_amdgcn_global_load_lds((const unsigned*)((const char*)(gbase) + voffB[_i]), (LAS unsigned*)(lds + (bufoff) + ldsw + _i * 8192), 16, 0, 0); } while (0)
#define PG8_STAGE_A(bufoff, gbase, v, h) do { _Pragma("unroll") for (int _i = 0; _i < 2; ++_i) \
        __builtin_amdgcn_global_load_lds((const unsigned*)((const char*)(gbase) + (v)[h][_i]), (LAS unsigned*)(lds + (bufoff) + ldsw + _i * 8192), 16, 0, 0); } while (0)
#define PG8_AOFF(u, v) do { int _t = tid; asm volatile("" : "+v"(_t)); _Pragma("unroll") for (int _i = 0; _i < 2; ++_i) { int _R, _C; stage_rc(_t * 16 + _i * 8192, _R, _C); \
        _Pragma("unroll") for (int _h = 0; _h < 2; ++_h) { const int _r = _h * HALF + _R; \
        (v)[_h][_i] = GATHER ? (S.gather_off((u), _r) + (unsigned)_C * 2u) : (unsigned)(_r * K + _C) * 2u; } } } while (0)
#define PG8_LDA(dst, b, h) do { _Pragma("unroll") for (int m = 0; m < 4; ++m) _Pragma("unroll") for (int k = 0; k < 2; ++k) dst[m][k] = *(const LAS bf16x8*)(lds + PG8_SA(b, h) + aoff + m * 2048 + k * 1024); } while (0)
#define PG8_LDB(dst, b, h) do { _Pragma("unroll") for (int n = 0; n < 2; ++n) _Pragma("unroll") for (int k = 0; k < 2; ++k) dst[n][k] = *(const LAS bf16x8*)(lds + PG8_SB(b, h) + boff + n * 2048 + k * 1024); } while (0)
#define PG8_MMA(ai, bj, At, Bt) do { __builtin_amdgcn_s_setprio(1); _Pragma("unroll") for (int m = 0; m < 4; ++m) _Pragma("unroll") for (int n = 0; n < 2; ++n) _Pragma("unroll") for (int k = 0; k < 2; ++k) \
        acc[ai][bj][m][n] = __builtin_amdgcn_mfma_f32_16x16x32_bf16(Bt[n][k], At[m][k], acc[ai][bj][m][n], 0, 0, 0); __builtin_amdgcn_s_setprio(0); } while (0)
#define PG8_WAIT_V(n) asm volatile("s_waitcnt vmcnt(" #n ")" ::: "memory")
#define PG8_WAIT_L(n) asm volatile("s_waitcnt lgkmcnt(" #n ")" ::: "memory")
#define PG8_BAR __builtin_amdgcn_s_barrier()
#define PG8_SCHED __builtin_amdgcn_sched_barrier(0)
    Unit cur, nxt; int ui = 0;
    if (!S.next(0, cur)) return;
    f32x4 acc[2][2][4][2];
#pragma unroll
    for (int a = 0; a < 2; ++a)
#pragma unroll
        for (int b = 0; b < 2; ++b)
#pragma unroll
            for (int m = 0; m < 4; ++m)
#pragma unroll
                for (int n = 0; n < 2; ++n) acc[a][b][m][n] = (f32x4){0.f, 0.f, 0.f, 0.f};
    bf16x8 At[4][2], B0[2][2], B1[2][2];
    unsigned vA[2][2], vN[2][2];
    PG8_AOFF(cur, vA);
    const char* cA = cur.a; const char* cB = cur.b;
    PG8_STAGE_B(PG8_SB(0, 0), cB); PG8_STAGE_B(PG8_SB(0, 1), cB + hstepB); PG8_STAGE_A(PG8_SA(0, 0), cA, vA, 0); PG8_STAGE_A(PG8_SA(0, 1), cA, vA, 1);
    if (wr == 1) PG8_BAR;
    PG8_WAIT_V(2); PG8_BAR;
    PG8_STAGE_B(PG8_SB(1, 0), cB + kstep); PG8_STAGE_A(PG8_SA(1, 0), cA + kstep, vA, 0); PG8_STAGE_B(PG8_SB(1, 1), cB + hstepB + kstep);
    PG8_WAIT_V(6); PG8_BAR;
    for (;;) {
        const bool has_next = S.next(ui + 1, nxt);
        const char* nA = has_next ? nxt.a : cA; const char* nB = has_next ? nxt.b : cB;
        if (GATHER) { if (has_next) { PG8_AOFF(nxt, vN); } else {
#pragma unroll
            for (int h = 0; h < 2; ++h)
#pragma unroll
                for (int i = 0; i < 2; ++i) vN[h][i] = vA[h][i]; } }
        for (int t = 0; t < nt; t += 2) {
            const bool last = (t == nt - 2);
            const char* a1 = cA + (size_t)(t + 1) * kstep;
            const char* a2 = last ? nA : cA + (size_t)(t + 2) * kstep; const char* b2 = last ? nB : cB + (size_t)(t + 2) * kstep;
            const char* a3 = a2 + kstep; const char* b3 = b2 + kstep;
            unsigned v2[2][2];
#pragma unroll
            for (int h = 0; h < 2; ++h)
#pragma unroll
                for (int i = 0; i < 2; ++i) v2[h][i] = (GATHER && last) ? vN[h][i] : vA[h][i];
            PG8_LDB(B0, 0, 0); PG8_LDB(B1, 0, 1); PG8_SCHED; PG8_LDA(At, 0, 0); PG8_STAGE_A(PG8_SA(1, 1), a1, vA, 1);
            PG8_WAIT_V(8); PG8_WAIT_L(0); PG8_BAR; if (cur.half != 1) { PG8_MMA(0, 0, At, B0); PG8_MMA(0, 1, At, B1); } PG8_BAR; PG8_SCHED;
            PG8_LDA(At, 0, 1); PG8_STAGE_B(PG8_SB(0, 0), b2); PG8_STAGE_B(PG8_SB(0, 1), b2 + hstepB); PG8_STAGE_A(PG8_SA(0, 0), a2, v2, 0);
            PG8_WAIT_V(8); PG8_WAIT_L(0); PG8_BAR; if (cur.half != 0) { PG8_MMA(1, 0, At, B0); PG8_MMA(1, 1, At, B1); } PG8_BAR; PG8_SCHED;
            PG8_LDB(B0, 1, 0); PG8_LDB(B1, 1, 1); PG8_SCHED; PG8_LDA(At, 1, 0); PG8_STAGE_A(PG8_SA(0, 1), a2, v2, 1);
            PG8_WAIT_V(8); PG8_WAIT_L(0); PG8_BAR; if (cur.half != 1) { PG8_MMA(0, 0, At, B0); PG8_MMA(0, 1, At, B1); } PG8_BAR; PG8_SCHED;
            PG8_LDA(At, 1, 1); PG8_STAGE_B(PG8_SB(1, 0), b3); PG8_STAGE_B(PG8_SB(1, 1), b3 + hstepB); PG8_STAGE_A(PG8_SA(1, 0), a3, v2, 0);
            PG8_WAIT_V(8); PG8_WAIT_L(0); PG8_BAR; if (cur.half != 0) { PG8_MMA(1, 0, At, B0); PG8_MMA(1, 1, At, B1); } PG8_BAR; PG8_SCHED;
        }
        if (wr == 0) PG8_BAR;
        E(acc, cur, wr, wc, fr, fq);
        if (!has_next) break;
#pragma unroll
        for (int a = 0; a < 2; ++a)
#pragma unroll
            for (int b = 0; b < 2; ++b)
#pragma unroll
                for (int m = 0; m < 4; ++m)
#pragma unroll
                    for (int n = 0; n < 2; ++n) acc[a][b][m][n] = (f32x4){0.f, 0.f, 0.f, 0.f};
        cur = nxt; cA = nA; cB = nB; ++ui;
#pragma unroll
        for (int h = 0; h < 2; ++h)
#pragma unroll
            for (int i = 0; i < 2; ++i) vA[h][i] = GATHER ? vN[h][i] : vA[h][i];
        if (wr == 1) PG8_BAR;
    }
    PG8_WAIT_V(0);
    PG8_BAR;
#undef PG8_SA
#undef PG8_SB
#undef PG8_STAGE_A
#undef PG8_STAGE_B
#undef PG8_AOFF
#undef PG8_LDA
#undef PG8_LDB
#undef PG8_MMA
#undef PG8_WAIT_V
#undef PG8_WAIT_L
#undef PG8_BAR
#undef PG8_SCHED
}
}

template <bool FRAG = false>
__device__ __forceinline__ void transpose_item(const float* W, int K, int N, bf16* WT, int k0, int n0, int drow0, LAS float* scr, int lane, const float* gk = nullptr) {
#pragma unroll
    for (int i = 0; i < 8; ++i) { const int kk = 8 * i + (lane >> 3), c4 = 4 * (lane & 7);
        f32x4 v = *(const f32x4*)(W + (size_t)(k0 + kk) * N + n0 + c4);
        if (gk) v = v * gk[k0 + kk];
        LAS float* d = scr + kk * 33 + c4; d[0] = v.x; d[1] = v.y; d[2] = v.z; d[3] = v.w; }
    asm volatile("s_waitcnt lgkmcnt(0)" ::: "memory");
    const int c = lane & 7;
#pragma unroll
    for (int j = 0; j < 4; ++j) { const int n = (lane >> 3) + 8 * j; const LAS float* s = scr + (8 * c) * 33 + n;
        v4u o; o.x = pk2(s[0 * 33], s[1 * 33]); o.y = pk2(s[2 * 33], s[3 * 33]); o.z = pk2(s[4 * 33], s[5 * 33]); o.w = pk2(s[6 * 33], s[7 * 33]);
        if (FRAG) { const int d = drow0 + n, k8 = (k0 >> 3) + c;
            *(v4u*)(WT + ((size_t)(((d >> 5) * (K >> 4) + (k8 >> 1)) * 64 + 32 * (k8 & 1) + (d & 31))) * 8) = o; }
        else *(v4u*)(WT + (size_t)(drow0 + n) * K + k0 + 8 * c) = o; }
    asm volatile("s_waitcnt lgkmcnt(0)" ::: "memory");
}
__device__ __forceinline__ void p_prologue(Frame& F) {
    p_prologue_rows(F);
    LAS float* scr = (LAS float*)(F.lds + F.wave * 16384);
    const int gw = F.bid * NWAVES + F.wave, NGW = F.G * NWAVES;
    constexpr int I_IN = (D / 64) * (NIN / 32), I_OUT = (D / 64) * (D / 32), I_G = (D / 64) * (DEXP / 32), I_D = (DEXP / 64) * (D / 32), I_E = 2 * I_G + I_D, LAY = I_IN + I_OUT + NEXP * I_E;
    for (int it = gw; it < DEPTH * LAY; it += NGW) {
        const int l = it / LAY; int r = it % LAY;
        if (r < I_IN) { const int nb = NIN / 32, kb = r / nb, n0 = 32 * (r % nb); transpose_item(F.w_in + (size_t)l * D * NIN, D, NIN, F.WIN_T + (size_t)l * NIN * D, 64 * kb, n0, n0, scr, F.lane, F.norm_mix + (size_t)l * D); continue; }
        r -= I_IN;
        if (r < I_OUT) { const int nb = D / 32, kb = r / nb, n0 = 32 * (r % nb); transpose_item(F.w_out + (size_t)l * D * D, D, D, F.WOUT_T + (size_t)l * D * D, 64 * kb, n0, n0, scr, F.lane); continue; }
        r -= I_OUT;
        const int e = r / I_E; int q = r % I_E; const size_t le = (size_t)(l * NEXP + e);
        if (q < 2 * I_G) { const int up = q >= I_G; q -= up * I_G; const int nb = DEXP / 32, kb = q / nb, n0 = 32 * (q % nb);
            transpose_item((up ? F.w_up : F.w_gate) + le * D * DEXP, D, DEXP, F.WGU_T + le * 2 * DEXP * D, 64 * kb, n0, ((n0 >> 7) << 8) + up * 128 + (n0 & 127), scr, F.lane, F.norm_ffn + (size_t)l * D); continue; }
        q -= 2 * I_G;
        { const int nb = D / 32, kb = q / nb, n0 = 32 * (q % nb); transpose_item(F.w_down + le * DEXP * D, DEXP, D, F.WD_T + le * D * DEXP, 64 * kb, n0, n0, scr, F.lane); }
    }
    for (int it = gw; it < DEPTH * 4 * 32; it += NGW) {
        const int lg = it >> 5, q = it & 31, kb = q >> 3, n0 = 32 * (q & 7);
        transpose_item<true>(F.w_pool + (size_t)lg * 65536, 256, 256, F.WP_T + (size_t)lg * 65536, 64 * kb, n0, n0, scr, F.lane);
    }
    const rsrc_t wrb = mk_rsrc(F.WR_T, MiB), ropeb = mk_rsrc(F.ROPE, 2 * MiB);
    for (int idx = F.bid * NTHREADS + F.tid; idx < DEPTH * 64 * D; idx += F.G * NTHREADS) {
        const int l = idx / (64 * D), col = (idx / D) & 63, k = idx & (D - 1);
        float v = 0.f;
        if (col < NEXP) v = F.w_re[((size_t)l * D + k) * NEXP + col]; else if (col < NEXP + 4) v = F.w_rg[((size_t)l * D + k) * 4 + (col - NEXP)];
        v *= F.norm_ffn[l * D + k];
        const unsigned h = f2bf(v); const float r = v - bf2f((bf16)h);
        const size_t fo = (((size_t)((col >> 5) * 4 + (k >> 9)) * 32 + ((k >> 4) & 31)) * 64 + 32 * ((k >> 3) & 1) + (col & 31)) * 8 + (k & 7);
        ST2(wrb, ((size_t)(l * 2 + 0) * 64 * D + fo) * 2, (short)h); ST2(wrb, ((size_t)(l * 2 + 1) * 64 * D + fo) * 2, (short)f2bf(r));
    }
    for (int idx = F.bid * NTHREADS + F.tid; idx < T * 16; idx += F.G * NTHREADS) {
        const int t = idx >> 4, i = idx & 15;
        const float f = exp2f(-(float)i * (18.931568569324174f / 16.0f)) * 0.15915494309189535f;
        const float p = (float)F.pos[t], hi = p * f, lo = fmaf(p, f, -hi);
        float rev = (hi - floorf(hi)) + lo;
        ST4(ropeb, ((size_t)t * 32 + i) * 4, __builtin_bit_cast(unsigned, __builtin_amdgcn_cosf(rev))); ST4(ropeb, ((size_t)t * 32 + 16 + i) * 4, __builtin_bit_cast(unsigned, __builtin_amdgcn_sinf(rev)));
    }
    __syncthreads();
}

__device__ __forceinline__ void p_gemm1(Frame& F, int l) {
    pg8::DenseOrder S; S.init(F.XRB, F.WIN_T + (size_t)l * NIN * D, T, NIN, D, F.G, F.bid);
    pg8::EpiZ E{mk_rsrc(F.Z, (size_t)T * NIN * 2), mk_rsrc(F.VT, (size_t)T * KVW * 2), l};
    pg8::gemm_phase<pg8::EpiZ, pg8::DenseOrder, false>(F.lds, F.tid, D, S, E);
}
__device__ __forceinline__ void p_gemm2(Frame& F, int l) {
    pg8::DenseOrder S; S.init(F.MIX, F.WOUT_T + (size_t)l * D * D, T, D, D, F.G, F.bid);
    pg8::EpiRes E{F.XRB, mk_rsrc(F.X1B, (size_t)T * D * 2)};
    pg8::gemm_phase<pg8::EpiRes, pg8::DenseOrder, false>(F.lds, F.tid, D, S, E);
}
__device__ __forceinline__ void p_moe_gu(Frame& F, int l) {
    load_counts(F, l, 2 * DEXP / 256);
    pg8::MoeOrder S; S.cnt_s = (const LAS int*)(F.lds + CNT_OFF); S.base_s = (const LAS int*)(F.lds + BASE_OFF); S.ustart = (const LAS int*)(F.lds + USTART_OFF);
    S.nN = 2 * DEXP / 256; S.G = F.G; S.c = F.bid; S.K = D; S.total = __builtin_amdgcn_readfirstlane(S.ustart[32]); S.gather = 1; S.A = (const char*)F.X1B; S.Bt = (const char*)(F.WGU_T + (size_t)l * NEXP * 2 * DEXP * D); S.b_estride = (size_t)2 * DEXP * D * 2; S.LIST = F.LIST;
    pg8::EpiSilu E{mk_rsrc(F.ABUF, (size_t)40960 * DEXP * 2), F.LIST, F.RS2};
    pg8::gemm_phase<pg8::EpiSilu, pg8::MoeOrder, true>(F.lds, F.tid, D, S, E);
}
__device__ __forceinline__ void p_moe_dn(Frame& F, int l) {
    load_counts(F, l, D / 256);
    pg8::MoeOrder S; S.cnt_s = (const LAS int*)(F.lds + CNT_OFF); S.base_s = (const LAS int*)(F.lds + BASE_OFF); S.ustart = (const LAS int*)(F.lds + USTART_OFF);
    S.nN = D / 256; S.G = F.G; S.c = F.bid; S.K = DEXP; S.total = __builtin_amdgcn_readfirstlane(S.ustart[32]); S.gather = 0; S.A = (const char*)F.ABUF; S.Bt = (const char*)(F.WD_T + (size_t)l * NEXP * D * DEXP); S.b_estride = (size_t)D * DEXP * 2; S.LIST = F.LIST;
    pg8::EpiScatter E{mk_rsrc(F.Y, (size_t)2 * T * D * 2), F.LIST, F.CW};
    pg8::gemm_phase<pg8::EpiScatter, pg8::MoeOrder, false>(F.lds, F.tid, DEXP, S, E);
}


typedef float f32x2_t __attribute__((ext_vector_type(2)));
typedef __bf16 bf16x2_t __attribute__((ext_vector_type(2)));
__device__ __forceinline__ unsigned cvtpk(float lo, float hi) { f32x2_t v = {lo, hi}; bf16x2_t b = __builtin_convertvector(v, bf16x2_t); return __builtin_bit_cast(unsigned, b); }
constexpr int MX_KP = 136, MX_VP = 36, MX_YP = 1032;
constexpr int MX_KBUF = 0, MX_KSTAGE = 2 * 32 * MX_KP * 2;
constexpr int MX_VBUF = 2 * MX_KSTAGE, MX_VSTAGE = 2 * 128 * MX_VP * 2;
constexpr int MX_YT = 0;
constexpr int MX_REDA = 122880, MX_REDP = MX_REDA + 1024;
constexpr int MX_OSTP = 272, MX_OSTW = 32 * MX_OSTP;
static_assert(MX_VBUF + 2 * MX_VSTAGE <= MX_REDA && 32 * MX_YP * 2 <= MX_REDA && 8 * MX_OSTW <= MX_REDA, "mixer LDS map");
__device__ __forceinline__ void mx_flush_tile(LAS unsigned char* tile, rsrc_t mix, size_t gbyte, int lane) {
    asm volatile("s_waitcnt lgkmcnt(0)" ::: "memory");
    const int rr = lane >> 4, cc = lane & 15;
#pragma unroll
    for (int k = 0; k < 8; ++k) { const v4u v = *(const LAS v4u*)(tile + (rr + 4 * k) * MX_OSTP + 16 * cc); ST16(mix, gbyte + ((size_t)(rr + 4 * k) * D + 8 * cc) * 2, v); }
}
template <int HW>
__device__ __forceinline__ void mx_ytile(const bf16* Z, LAS unsigned char* lds, int b, int s0, int w, int lane) {
    constexpr int NJ = 7 + 2 * HW;
    const int c = 32 * (w >> 1) + (lane & 31), r0 = 8 * (2 * (w & 1) + (lane >> 5)), sb = s0 + r0;
    const bf16* base = Z + (size_t)(b * SEQ) * NIN + 8 * c;
    v4u raw[NJ];
#pragma unroll
    for (int j = 0; j < NJ; ++j) { const int row = sb - HW + j; const bool ok = (unsigned)row < (unsigned)SEQ;
        v4u t = *(const v4u*)(base + (size_t)(ok ? row : sb) * NIN);
        t.x = ok ? t.x : 0u; t.y = ok ? t.y : 0u; t.z = ok ? t.z : 0u; t.w = ok ? t.w : 0u; raw[j] = t; }
    float a[8];
#pragma unroll
    for (int e = 0; e < 8; ++e) a[e] = 0.f;
#pragma unroll
    for (int j = 0; j < 2 * HW; ++j) { a[0] += bflo(raw[j].x); a[1] += bfhi(raw[j].x); a[2] += bflo(raw[j].y); a[3] += bfhi(raw[j].y); a[4] += bflo(raw[j].z); a[5] += bfhi(raw[j].z); a[6] += bflo(raw[j].w); a[7] += bfhi(raw[j].w); }
#pragma unroll
    for (int i = 0; i < 8; ++i) {
        const int s = sb + i, lo = s - HW < 0 ? 0 : s - HW, hi_ = s + HW > SEQ ? SEQ : s + HW;
        const float inv = 1.0f / (float)(hi_ - lo);
        const v4u cr = raw[HW + i];
        v4u pk; pk.x = cvtpk(a[0] * inv - bflo(cr.x), a[1] * inv - bfhi(cr.x)); pk.y = cvtpk(a[2] * inv - bflo(cr.y), a[3] * inv - bfhi(cr.y));
        pk.z = cvtpk(a[4] * inv - bflo(cr.z), a[5] * inv - bfhi(cr.z)); pk.w = cvtpk(a[6] * inv - bflo(cr.w), a[7] * inv - bfhi(cr.w));
        *(LAS v4u*)(lds + MX_YT + ((r0 + i) * MX_YP + 8 * c) * 2) = pk;
        if (i < 7) { const v4u p = raw[i + 2 * HW], q = raw[i];
            a[0] += bflo(p.x) - bflo(q.x); a[1] += bfhi(p.x) - bfhi(q.x); a[2] += bflo(p.y) - bflo(q.y); a[3] += bfhi(p.y) - bfhi(q.y);
            a[4] += bflo(p.z) - bflo(q.z); a[5] += bfhi(p.z) - bfhi(q.z); a[6] += bflo(p.w) - bflo(q.w); a[7] += bfhi(p.w) - bfhi(q.w); }
    }
}
__device__ __forceinline__ void p_mix(Frame& F, int l) {
    const rsrc_t mixb = mk_rsrc(F.MIX, (size_t)T * D * 2);
    const int w = F.wave, kvh = w >> 2;
    LAS unsigned char* lds = F.lds;
    LAS float* redA = (LAS float*)(lds + MX_REDA); LAS float* redP = (LAS float*)(lds + MX_REDP);
    const float LOG2E = 1.4426950408889634f;
    const float sinkv = F.sink[l * NQH + w] * LOG2E;
    const int vcu = (F.G % 8 == 0) ? (F.bid % 8) * (F.G / 8) + F.bid / 8 : F.bid;
    const int per = (T / 32 + F.G - 1) / F.G;
    for (int ii = 0; ii < per; ++ii) {
        const int it = vcu * per + ii;
        if (it >= T / 32) break;
        int tid = F.tid; asm volatile("" : "+v"(tid));
        const int lane = tid & 63, r32 = lane & 31, hi = lane >> 5;
        const int skey = tid >> 4, sc = tid & 15, vdim = tid >> 2, vc = tid & 3;
        const int t0 = it * 32, b = t0 >> 11, s0 = t0 & (SEQ - 1);
        const int kt_lo = (s0 >= 128) ? 0 : ((128 - s0) >> 5);
        const int kt_hi = ((SEQ + 96 - s0) >> 5) > 8 ? 8 : ((SEQ + 96 - s0) >> 5);
        bf16x8 qf[8];
        {
            const bf16* qrow = F.Z + (size_t)(t0 + r32) * NIN + POOLW + w * HD + 8 * hi;
            float qv[8][8]; float ssq = 0.f;
#pragma unroll
            for (int s = 0; s < 8; ++s) { const v4u raw = *(const v4u*)(qrow + 16 * s);
                qv[s][0] = bflo(raw.x); qv[s][1] = bfhi(raw.x); qv[s][2] = bflo(raw.y); qv[s][3] = bfhi(raw.y); qv[s][4] = bflo(raw.z); qv[s][5] = bfhi(raw.z); qv[s][6] = bflo(raw.w); qv[s][7] = bfhi(raw.w);
#pragma unroll
                for (int j = 0; j < 8; ++j) ssq += qv[s][j] * qv[s][j]; }
            ssq += __shfl_xor(ssq, 32);
            const float rstd = (0.08838834764831845f * LOG2E) / sqrtf(ssq * (1.0f / HD) + EPS);
            const float* qn = F.q_norm + l * HD + 8 * hi;
#pragma unroll
            for (int s = 0; s < 8; ++s) { const f32x4 g0 = *(const f32x4*)(qn + 16 * s), g1 = *(const f32x4*)(qn + 16 * s + 4);
                qv[s][0] *= rstd * g0.x; qv[s][1] *= rstd * g0.y; qv[s][2] *= rstd * g0.z; qv[s][3] *= rstd * g0.w; qv[s][4] *= rstd * g1.x; qv[s][5] *= rstd * g1.y; qv[s][6] *= rstd * g1.z; qv[s][7] *= rstd * g1.w; }
            const float* rp = F.ROPE + (size_t)(t0 + r32) * 32 + 8 * hi;
            const f32x4 c0 = *(const f32x4*)rp, c1 = *(const f32x4*)(rp + 4), s0v = *(const f32x4*)(rp + 16), s1v = *(const f32x4*)(rp + 20);
            const float cs[8] = {c0.x, c0.y, c0.z, c0.w, c1.x, c1.y, c1.z, c1.w}, sn[8] = {s0v.x, s0v.y, s0v.z, s0v.w, s1v.x, s1v.y, s1v.z, s1v.w};
#pragma unroll
            for (int j = 0; j < 8; ++j) { const float x1 = qv[0][j], x2 = qv[1][j]; qv[0][j] = x1 * cs[j] - x2 * sn[j]; qv[1][j] = x2 * cs[j] + x1 * sn[j]; }
#pragma unroll
            for (int s = 0; s < 8; ++s) { v4u pk; pk.x = cvtpk(qv[s][0], qv[s][1]); pk.y = cvtpk(qv[s][2], qv[s][3]); pk.z = cvtpk(qv[s][4], qv[s][5]); pk.w = cvtpk(qv[s][6], qv[s][7]); qf[s] = __builtin_bit_cast(bf16x8, pk); }
        }
        f32x16 O[4];
#pragma unroll
        for (int db = 0; db < 4; ++db)
#pragma unroll
            for (int i = 0; i < 16; ++i) O[db][i] = 0.f;
        float m = sinkv, lsum = 1.0f;
        v4u kraw0, kraw1, vraw0, vraw1;
#define MX_LOAD(kt) do { const int ks_ = s0 - 128 + 32 * (kt); const size_t krow_ = (size_t)(b * SEQ + ks_ + skey); \
            kraw0 = *(const v4u*)(F.Z + krow_ * NIN + POOLW + ATTW + 8 * sc); kraw1 = *(const v4u*)(F.Z + krow_ * NIN + POOLW + ATTW + HD + 8 * sc); \
            vraw0 = *(const v4u*)(F.VT + ((size_t)((b * 2 + 0) * HD + vdim)) * SEQ + ks_ + 8 * vc); vraw1 = *(const v4u*)(F.VT + ((size_t)((b * 2 + 1) * HD + vdim)) * SEQ + ks_ + 8 * vc); } while (0)
#define MX_KROW(raw, kv, sb) do { *(LAS v4u*)(lds + MX_KBUF + (sb) * MX_KSTAGE + (((kv) * 32 + skey) * MX_KP + 8 * sc) * 2) = raw; } while (0)
#define MX_STORE(sb) do { MX_KROW(kraw0, 0, sb); MX_KROW(kraw1, 1, sb); \
            { LAS unsigned char* vp_ = lds + MX_VBUF + (sb) * MX_VSTAGE + ((0 * 128 + vdim) * MX_VP + 8 * vc) * 2; v2u a_; a_.x = vraw0.x; a_.y = vraw0.y; *(LAS v2u*)vp_ = a_; a_.x = vraw0.z; a_.y = vraw0.w; *(LAS v2u*)(vp_ + 8) = a_; } \
            { LAS unsigned char* vp_ = lds + MX_VBUF + (sb) * MX_VSTAGE + ((1 * 128 + vdim) * MX_VP + 8 * vc) * 2; v2u a_; a_.x = vraw1.x; a_.y = vraw1.y; *(LAS v2u*)vp_ = a_; a_.x = vraw1.z; a_.y = vraw1.w; *(LAS v2u*)(vp_ + 8) = a_; } } while (0)
        MX_LOAD(kt_lo);
        for (int kt = kt_lo; kt <= kt_hi; ++kt) {
            const int sb = (kt - kt_lo) & 1;
            MX_STORE(sb);
            if (kt < kt_hi) MX_LOAD(kt + 1);
            __syncthreads();
            f32x16 S;
#pragma unroll
            for (int i = 0; i < 16; ++i) S[i] = 0.f;
            const LAS unsigned char* kb = lds + MX_KBUF + sb * MX_KSTAGE + ((kvh * 32 + r32) * MX_KP + 8 * hi) * 2;
            { bf16x8 kf[8];
#pragma unroll
              for (int s = 0; s < 8; ++s) kf[s] = *(const LAS bf16x8*)(kb + 32 * s);
              __builtin_amdgcn_sched_barrier(0);
#pragma unroll
              for (int s = 0; s < 8; ++s) S = MFMA32(kf[s], qf[s], S);
              __builtin_amdgcn_sched_barrier(0); }
            asm volatile("s_nop 7\n\ts_nop 4" : "+v"(S));
            if (kt == 0) {
#pragma unroll
                for (int i = 0; i < 16; ++i) if (crow(i, hi) < r32) S[i] = -INFINITY;
            }
            if (kt == 8) {
#pragma unroll
                for (int i = 0; i < 16; ++i) if (crow(i, hi) > r32) S[i] = -INFINITY;
            }
            float mx = S[0];
#pragma unroll
            for (int i = 1; i < 16; ++i) mx = fmaxf(mx, S[i]);
            mx = fmaxf(mx, __shfl_xor(mx, 32));
            const float mn = fmaxf(m, mx), alpha = __builtin_amdgcn_exp2f(m - mn);
            float p[16]; float rs = 0.f;
#pragma unroll
            for (int i = 0; i < 16; ++i) { p[i] = __builtin_amdgcn_exp2f(S[i] - mn); rs += p[i]; }
            rs += __shfl_xor(rs, 32);
            lsum = lsum * alpha + rs; m = mn;
#pragma unroll
            for (int db = 0; db < 4; ++db) O[db] = O[db] * alpha;
            v4u pk0, pk1;
            pk0.x = cvtpk(p[0], p[1]); pk0.y = cvtpk(p[2], p[3]); pk0.z = cvtpk(p[4], p[5]); pk0.w = cvtpk(p[6], p[7]);
            pk1.x = cvtpk(p[8], p[9]); pk1.y = cvtpk(p[10], p[11]); pk1.z = cvtpk(p[12], p[13]); pk1.w = cvtpk(p[14], p[15]);
            const bf16x8 pf0 = __builtin_bit_cast(bf16x8, pk0), pf1 = __builtin_bit_cast(bf16x8, pk1);
            const LAS unsigned char* vb = lds + MX_VBUF + sb * MX_VSTAGE + ((kvh * 128 + r32) * MX_VP + 4 * hi) * 2;
            { v4u vv[4][2];
#pragma unroll
              for (int db = 0; db < 4; ++db)
#pragma unroll
                for (int s2 = 0; s2 < 2; ++s2) {
                    const v2u lo8 = *(const LAS v2u*)(vb + (32 * db * MX_VP + 16 * s2) * 2), hi8 = *(const LAS v2u*)(vb + (32 * db * MX_VP + 16 * s2 + 8) * 2);
                    vv[db][s2].x = lo8.x; vv[db][s2].y = lo8.y; vv[db][s2].z = hi8.x; vv[db][s2].w = hi8.y; }
              __builtin_amdgcn_sched_barrier(0);
#pragma unroll
              for (int db = 0; db < 4; ++db)
#pragma unroll
                for (int s2 = 0; s2 < 2; ++s2) O[db] = MFMA32(__builtin_bit_cast(bf16x8, vv[db][s2]), s2 ? pf1 : pf0, O[db]);
              __builtin_amdgcn_sched_barrier(0); }
        }
#undef MX_LOAD
#undef MX_KROW
#undef MX_STORE
        {
            const float inv = 1.0f / lsum; float ss = 0.f;
#pragma unroll
            for (int db = 0; db < 4; ++db) { O[db] = O[db] * inv;
#pragma unroll
                for (int i = 0; i < 16; ++i) ss += O[db][i] * O[db][i]; }
            ss += __shfl_xor(ss, 32);
            if (hi == 0) redA[w * 32 + r32] = ss;
        }
        __syncthreads();
        {
            float tot = 0.f;
#pragma unroll
            for (int h8 = 0; h8 < 8; ++h8) tot += redA[h8 * 32 + r32];
            const float rstd_a = 1.0f / sqrtf(tot * (1.0f / ATTW) + EPS);
            const float* ga = F.g_attn + l * ATTW + w * HD + 4 * hi;
            LAS unsigned char* ost = lds + w * MX_OSTW + r32 * MX_OSTP + 8 * hi;
#pragma unroll
            for (int db = 0; db < 4; ++db)
#pragma unroll
                for (int g4 = 0; g4 < 4; ++g4) { const f32x4 gg = *(const f32x4*)(ga + 32 * db + 8 * g4);
                    v2u o; o.x = cvtpk(O[db][4 * g4 + 0] * rstd_a * gg.x, O[db][4 * g4 + 1] * rstd_a * gg.y); o.y = cvtpk(O[db][4 * g4 + 2] * rstd_a * gg.z, O[db][4 * g4 + 3] * rstd_a * gg.w);
                    *(LAS v2u*)(ost + (32 * db + 8 * g4) * 2) = o; }
            mx_flush_tile(lds + w * MX_OSTW, mixb, ((size_t)t0 * D + POOLW + w * HD) * 2, lane);
        }
        __syncthreads();
        switch (w >> 1) {
            case 0: mx_ytile<1>(F.Z, lds, b, s0, w, lane); break;
            case 1: mx_ytile<2>(F.Z, lds, b, s0, w, lane); break;
            case 2: mx_ytile<4>(F.Z, lds, b, s0, w, lane); break;
            default: mx_ytile<8>(F.Z, lds, b, s0, w, lane); break;
        }
        __syncthreads();
        {
            const int g = w >> 1, ch = w & 1;
            f32x16 acc[4];
#pragma unroll
            for (int cb = 0; cb < 4; ++cb)
#pragma unroll
                for (int i = 0; i < 16; ++i) acc[cb][i] = 0.f;
            const bf16* wp = F.WP_T + (size_t)(l * 4 + g) * 65536 + (size_t)(4 * ch) * 16 * 512 + (size_t)lane * 8;
            const LAS unsigned char* yb = lds + MX_YT + (r32 * MX_YP + 256 * g + 8 * hi) * 2;
            bf16x8 wfa[16], wfb[16];
#pragma unroll
            for (int s = 0; s < 16; ++s) wfa[s] = *(const bf16x8*)(wp + (size_t)s * 512);
            __builtin_amdgcn_sched_barrier(0);
#pragma unroll
            for (int cb = 0; cb < 4; ++cb) {
                if (cb < 3) {
#pragma unroll
                    for (int s = 0; s < 16; ++s) { const bf16x8 t = *(const bf16x8*)(wp + (size_t)((cb + 1) * 16 + s) * 512); if (cb & 1) wfa[s] = t; else wfb[s] = t; }
                }
                __builtin_amdgcn_sched_barrier(0);
#pragma unroll
                for (int s = 0; s < 16; ++s) { const bf16x8 yf = *(const LAS bf16x8*)(yb + 32 * s); acc[cb] = MFMA32((cb & 1) ? wfb[s] : wfa[s], yf, acc[cb]); }
                __builtin_amdgcn_sched_barrier(0);
            }
            const int colb = 256 * g + 128 * ch + 4 * hi;
            const float* ps = F.pool_scale + l * POOLW + colb;
            float ss = 0.f;
#pragma unroll
            for (int cb = 0; cb < 4; ++cb)
#pragma unroll
                for (int g4 = 0; g4 < 4; ++g4) { const f32x4 sc4 = *(const f32x4*)(ps + 32 * cb + 8 * g4);
                    acc[cb][4 * g4 + 0] *= sc4.x; acc[cb][4 * g4 + 1] *= sc4.y; acc[cb][4 * g4 + 2] *= sc4.z; acc[cb][4 * g4 + 3] *= sc4.w;
#pragma unroll
                    for (int e = 0; e < 4; ++e) ss += acc[cb][4 * g4 + e] * acc[cb][4 * g4 + e]; }
            ss += __shfl_xor(ss, 32);
            if (hi == 0) redP[w * 32 + r32] = ss;
            __syncthreads();
            float tot = 0.f;
#pragma unroll
            for (int w8 = 0; w8 < 8; ++w8) tot += redP[w8 * 32 + r32];
            const float rstd_p = 1.0f / sqrtf(tot * (1.0f / POOLW) + EPS);
            const float* gp = F.g_pool + l * POOLW + colb;
            LAS unsigned char* ost = lds + w * MX_OSTW + r32 * MX_OSTP + 8 * hi;
#pragma unroll
            for (int cb = 0; cb < 4; ++cb)
#pragma unroll
                for (int g4 = 0; g4 < 4; ++g4) { const f32x4 gg = *(const f32x4*)(gp + 32 * cb + 8 * g4);
                    v2u o; o.x = cvtpk(acc[cb][4 * g4 + 0] * rstd_p * gg.x, acc[cb][4 * g4 + 1] * rstd_p * gg.y); o.y = cvtpk(acc[cb][4 * g4 + 2] * rstd_p * gg.z, acc[cb][4 * g4 + 3] * rstd_p * gg.w);
                    *(LAS v2u*)(ost + (32 * cb + 8 * g4) * 2) = o; }
            mx_flush_tile(lds + w * MX_OSTW, mixb, ((size_t)t0 * D + 256 * g + 128 * ch) * 2, lane);
        }
        __syncthreads();
    }
    __syncthreads();
}


constexpr int RT_PART = 0;
constexpr int RT_RSTD = 65536;
constexpr int RT_TOKE = 65536 + 256, RT_TOKC = RT_TOKE + 512, RT_TOKP = RT_TOKC + 512, RT_LCNT = RT_TOKP + 512, RT_GBASE = RT_LCNT + 128;
__device__ __forceinline__ void p_router(Frame& F, int l) {
    const RtOut R{F.LIST, F.CW, (unsigned*)(F.ctl + CW_CNT) + l * 32 * 64, nullptr};
    const rsrc_t hb = mk_rsrc(F.HB, (size_t)T * D * 2), lstb = mk_rsrc(F.LIST, (size_t)NEXP * T * 4), cwb = mk_rsrc(F.CW, (size_t)2 * T * 4);
    LAS unsigned char* lds = F.lds;
    LAS float* part = (LAS float*)(lds + RT_PART); LAS float* rstd_s = (LAS float*)(lds + RT_RSTD);
    LAS int* tok_e = (LAS int*)(lds + RT_TOKE); LAS float* tok_c = (LAS float*)(lds + RT_TOKC); LAS int* tok_p = (LAS int*)(lds + RT_TOKP);
    LAS int* lcnt = (LAS int*)(lds + RT_LCNT); LAS int* gbase = (LAS int*)(lds + RT_GBASE);
    const int w = F.wave;
    const float* gf = F.norm_ffn + (size_t)l * D;
    unsigned* cnt = R.cnt;
    for (int chunk = F.bid; chunk < T / 64; chunk += F.G) {
        int tid = F.tid; asm volatile("" : "+v"(tid));
        const int lane = tid & 63, r32 = lane & 31, hi = lane >> 5;
        __syncthreads();
        if (tid < 32) lcnt[tid] = 0;
        {
            v4u cu[4], nx[4];
            { const v4u* xr = (const v4u*)(F.X1B + (size_t)(chunk * 64 + w * 8) * D);
#pragma unroll
              for (int j = 0; j < 4; ++j) cu[j] = xr[j * 64 + lane]; }
#pragma unroll 1
            for (int i = 0; i < 8; ++i) {
                const int ti = w * 8 + i, t = chunk * 64 + ti;
                if (i < 7) { const v4u* xr = (const v4u*)(F.X1B + (size_t)(t + 1) * D);
#pragma unroll
                    for (int j = 0; j < 4; ++j) nx[j] = xr[j * 64 + lane]; }
                __builtin_amdgcn_sched_barrier(0);
                float xv[4][8];
#pragma unroll
                for (int j = 0; j < 4; ++j) unpack8(cu[j], xv[j]);
                float ss_ = 0.f;
#pragma unroll
                for (int j = 0; j < 4; ++j)
#pragma unroll
                    for (int e = 0; e < 8; ++e) ss_ += xv[j][e] * xv[j][e];
                const float rstd = 1.0f / sqrtf(wave_sum(ss_) * (1.0f / D) + EPS);
                if (lane == 0) { rstd_s[ti] = rstd; F.RS2[t] = rstd; }
#pragma unroll
                for (int j = 0; j < 4; ++j) cu[j] = nx[j];
            }
        }
        {
            const int tile = w >> 2, kq = w & 3;
            f32x16 a0, a1;
#pragma unroll
            for (int i = 0; i < 16; ++i) { a0[i] = 0.f; a1[i] = 0.f; }
            const bf16* xp = F.X1B + (size_t)(chunk * 64 + tile * 32 + r32) * D + kq * 512 + 8 * hi;
            const bf16* wh = F.WR_T + (size_t)(l * 2 + 0) * 64 * D + (size_t)kq * 32 * 512 + lane * 8;
            const bf16* wl = F.WR_T + (size_t)(l * 2 + 1) * 64 * D + (size_t)kq * 32 * 512 + lane * 8;
            bf16x8 fx[2][4], fh0[2][4], fl0[2][4], fh1[2][4], fl1[2][4];
#define RT_LOADB(bf, q) do { _Pragma("unroll") for (int i = 0; i < 4; ++i) { const int s_ = 4 * (q) + i; fx[bf][i] = *(const bf16x8*)(xp + 16 * s_); \
                fh0[bf][i] = *(const bf16x8*)(wh + 512 * s_); fl0[bf][i] = *(const bf16x8*)(wl + 512 * s_); fh1[bf][i] = *(const bf16x8*)(wh + 4 * 32 * 512 + 512 * s_); fl1[bf][i] = *(const bf16x8*)(wl + 4 * 32 * 512 + 512 * s_); } } while (0)
            RT_LOADB(0, 0);
            __builtin_amdgcn_sched_barrier(0);
#pragma unroll
            for (int q = 0; q < 8; ++q) {
                if (q < 7) { if (q & 1) RT_LOADB(0, q + 1); else RT_LOADB(1, q + 1); }
                __builtin_amdgcn_sched_barrier(0);
#pragma unroll
                for (int i = 0; i < 4; ++i) { const int bf = q & 1;
                    a0 = MFMA32(fh0[bf][i], fx[bf][i], a0); a0 = MFMA32(fl0[bf][i], fx[bf][i], a0);
                    a1 = MFMA32(fh1[bf][i], fx[bf][i], a1); a1 = MFMA32(fl1[bf][i], fx[bf][i], a1); }
                __builtin_amdgcn_sched_barrier(0);
            }
#undef RT_LOADB
#pragma unroll
            for (int i = 0; i < 16; ++i) { part[(w * 32 + i) * 64 + lane] = a0[i]; part[(w * 32 + 16 + i) * 64 + lane] = a1[i]; }
        }
        __syncthreads();
        if ((w & 3) == 0) {
            const int ti = (w >> 2) * 32 + r32;
            float e16[16], g4v[4];
#pragma unroll
            for (int i = 0; i < 16; ++i) e16[i] = ((part[((w + 0) * 32 + i) * 64 + lane] + part[((w + 1) * 32 + i) * 64 + lane]) + part[((w + 2) * 32 + i) * 64 + lane]) + part[((w + 3) * 32 + i) * 64 + lane];
#pragma unroll
            for (int i = 0; i < 4; ++i) g4v[i] = ((part[((w + 0) * 32 + 16 + i) * 64 + lane] + part[((w + 1) * 32 + 16 + i) * 64 + lane]) + part[((w + 2) * 32 + 16 + i) * 64 + lane]) + part[((w + 3) * 32 + 16 + i) * 64 + lane];
            const float rstd = rstd_s[ti];
            float lg[4];
#pragma unroll
            for (int q = 0; q < 4; ++q) lg[q] = __shfl(g4v[q], r32) * rstd + F.b_rg[l * 4 + q];
            int gi = 0; float gm = lg[0];
#pragma unroll
            for (int q = 1; q < 4; ++q) if (lg[q] > gm) { gm = lg[q]; gi = q; }
            float gs = 0.f;
#pragma unroll
            for (int q = 0; q < 4; ++q) gs += expf(lg[q] - gm);
            const float g_w = 1.0f / gs;
            float mine[4], theirs[4];
#pragma unroll
            for (int q = 0; q < 4; ++q) { float vsel = e16[q];
#pragma unroll
                for (int g2 = 1; g2 < 4; ++g2) vsel = (gi == g2) ? e16[4 * g2 + q] : vsel;
                mine[q] = vsel * rstd + F.b_re[l * NEXP + gi * 8 + 4 * hi + q]; theirs[q] = __shfl_xor(mine[q], 32); }
            float sel[8];
#pragma unroll
            for (int q = 0; q < 4; ++q) { sel[q] = hi ? theirs[q] : mine[q]; sel[4 + q] = hi ? mine[q] : theirs[q]; }
            int i0 = 0; float m0 = sel[0];
#pragma unroll
            for (int q = 1; q < 8; ++q) if (sel[q] > m0) { m0 = sel[q]; i0 = q; }
            int i1 = -1; float m1 = -INFINITY;
#pragma unroll
            for (int q = 0; q < 8; ++q) if (q != i0 && sel[q] > m1) { m1 = sel[q]; i1 = q; }
            const float w0 = 1.0f / (1.0f + expf(m1 - m0)), w1 = 1.0f - w0;
            if (hi == 0) { tok_e[ti * 2] = gi * 8 + i0; tok_e[ti * 2 + 1] = gi * 8 + i1; tok_c[ti * 2] = g_w * w0; tok_c[ti * 2 + 1] = g_w * w1; }
        }
        __syncthreads();
        if (tid < 128) tok_p[tid] = atomicAdd((int*)&lcnt[tok_e[tid]], 1);
        __syncthreads();
        if (tid < 32) gbase[tid] = (int)__hip_atomic_fetch_add(cnt + tid * 64, (unsigned)lcnt[tid], RLX_AGENT);
        __syncthreads();
        if (tid < 128) { const int e = tok_e[tid], slot = (chunk * 64 + (tid >> 1)) * 2 + (tid & 1);
            ST4(lstb, ((size_t)e * T + gbase[e] + tok_p[tid]) * 4, (unsigned)slot); ST4(cwb, (size_t)slot * 4, __builtin_bit_cast(unsigned, tok_c[tid])); }
    }
    __syncthreads();
}
#define CAS __attribute__((address_space(4)))
__device__ __forceinline__ void build_frame(Frame& F, LAS unsigned char* lds) {
    const CAS Args* ka = (const CAS Args*)__builtin_amdgcn_kernarg_segment_ptr();
    asm volatile("" : "+s"(ka));
    F.lds = lds;
    int t_ = threadIdx.x; asm volatile("" : "+v"(t_));
    F.tid = t_; F.lane = F.tid & 63; F.wave = __builtin_amdgcn_readfirstlane(F.tid >> 6);
    { int g_ = gridDim.x, b_ = blockIdx.x; asm volatile("" : "+s"(g_), "+s"(b_)); F.G = g_; F.bid = b_; }
    unsigned char* ws = ka->ws;
    F.ctl = (gu32*)(ws + WS_CTL);
    F.x = (const float*)ka->in[0]; F.pos = (const int*)ka->in[1]; F.norm_mix = (const float*)ka->in[2]; F.w_in = (const float*)ka->in[3];
    F.w_pool = (const float*)ka->in[4]; F.pool_scale = (const float*)ka->in[5]; F.q_norm = (const float*)ka->in[6]; F.k_norm = (const float*)ka->in[7];
    F.sink = (const float*)ka->in[8]; F.g_pool = (const float*)ka->in[9]; F.g_attn = (const float*)ka->in[10]; F.w_out = (const float*)ka->in[11];
    F.norm_ffn = (const float*)ka->in[12]; F.w_rg = (const float*)ka->in[13]; F.b_rg = (const float*)ka->in[14]; F.w_re = (const float*)ka->in[15];
    F.b_re = (const float*)ka->in[16]; F.w_gate = (const float*)ka->in[17]; F.w_up = (const float*)ka->in[18]; F.w_down = (const float*)ka->in[19];
    F.out = ka->out;
    F.HB = (bf16*)(ws + WS_HB); F.Z = (bf16*)(ws + WS_Z); F.VT = (bf16*)(ws + WS_VT); F.MIX = (bf16*)(ws + WS_MIX); F.ABUF = (bf16*)(ws + WS_ABUF); F.Y = (bf16*)(ws + WS_Y);
    F.LIST = (int*)(ws + WS_LIST); F.CW = (float*)(ws + WS_CW);
    F.WIN_T = (bf16*)(ws + WS_WIN); F.WOUT_T = (bf16*)(ws + WS_WOUT); F.WGU_T = (bf16*)(ws + WS_WGU); F.WD_T = (bf16*)(ws + WS_WD); F.WP_T = (bf16*)(ws + WS_WPOOL); F.ROPE = (float*)(ws + WS_ROPE); F.WR_T = (bf16*)(ws + WS_WR); F.XRB = (bf16*)(ws + WS_XRB); F.X1B = (bf16*)(ws + WS_X1B); F.RS2 = (float*)(ws + WS_RS2); F.RS1 = (float*)(ws + WS_RS1);
}

#define LDS0 ((LAS unsigned char*)(unsigned)0u)
__global__ void __launch_bounds__(NTHREADS, 2) fwd(Args args) {
    extern __shared__ __attribute__((aligned(16))) unsigned char lds[];
    Frame F; build_frame(F, (LAS unsigned char*)lds);
    for (int u = F.tid; u < (LDS_BYTES - LDSCTL_OFF) / 4; u += NTHREADS) ((LAS unsigned*)(F.lds + LDSCTL_OFF))[u] = 0u;
    __syncthreads();
    if (START_DELAY_TICKS) { const unsigned long long t0_ = __builtin_amdgcn_s_memrealtime(); while (__builtin_amdgcn_s_memrealtime() - t0_ < START_DELAY_TICKS) __builtin_amdgcn_s_sleep(8); }
    const int lo = args.ph_lo, hi = args.ph_hi;
    const bool use_bar = (hi - lo) > 1;
    XcdBarrier bar; bar.bar = (unsigned*)(F.ctl + CW_BAR) + args.li * XCD_BAR_WORDS; bar.x = 0; bar.st = nullptr;
    if (use_bar) bar = xcd_barrier_post((unsigned*)(F.ctl + CW_BAR) + args.li * XCD_BAR_WORDS, (volatile LAS unsigned*)(LDS0 + MISC_OFF + 32));
#define IN(k) (lo <= (k) && (k) < hi)
#define SEAM(k) do { if (IN(k) && IN((k) + 1)) xcd_barrier(bar); } while (0)
    if (IN(0)) { build_frame(F, LDS0); p_prologue(F); SEAM(0); }
    for (int l = 0; l < DEPTH; ++l) {
        const int p0 = 1 + 7 * l;
        if (IN(p0 + 0)) { build_frame(F, LDS0); p_gemm1(F, l); SEAM(p0 + 0); }
        if (IN(p0 + 1)) { build_frame(F, LDS0); p_mix(F, l); SEAM(p0 + 1); }
        if (IN(p0 + 2)) { build_frame(F, LDS0); p_gemm2(F, l); SEAM(p0 + 2); }
        if (IN(p0 + 3)) { build_frame(F, LDS0); p_router(F, l); SEAM(p0 + 3); }
        if (IN(p0 + 4)) { build_frame(F, LDS0); p_moe_gu(F, l); SEAM(p0 + 4); }
        if (IN(p0 + 5)) { build_frame(F, LDS0); p_moe_dn(F, l); SEAM(p0 + 5); }
        if (IN(p0 + 6)) { build_frame(F, LDS0); p_combine(F, l); SEAM(p0 + 6); }
    }
#undef IN
#undef SEAM
}

extern "C" void kernel_launch(void* const* d_in, const int* in_sizes, int n_in, void* d_out, int out_size, void* d_ws, size_t ws_size, hipStream_t stream) {
    static int grid = 0;
    if (grid == 0) {
        if (n_in != 20 || in_sizes[0] != T * D || out_size != T * D || ws_size < WS_END) {
            fprintf(stderr, "kernel_launch: unexpected shapes: n_in %d in0 %d out %d ws %zu (need %zu)\n", n_in, n_in > 0 ? in_sizes[0] : -1, out_size, ws_size, (size_t)WS_END); grid = -1; return; }
        int dev = 0, cus = 0, per_cu = 0;
        if (hipGetDevice(&dev) != hipSuccess || hipDeviceGetAttribute(&cus, hipDeviceAttributeMultiprocessorCount, dev) != hipSuccess) { grid = -1; return; }
        if (hipFuncSetAttribute((const void*)fwd, hipFuncAttributeMaxDynamicSharedMemorySize, LDS_BYTES) != hipSuccess) { fprintf(stderr, "kernel_launch: hipFuncSetAttribute failed\n"); grid = -1; return; }
        if (hipOccupancyMaxActiveBlocksPerMultiprocessor(&per_cu, (const void*)fwd, NTHREADS, LDS_BYTES) != hipSuccess || per_cu < 1)
            fprintf(stderr, "kernel_launch: occupancy query reports %d blocks per CU\n", per_cu);
        (void)hipGetLastError();
        grid = cus;
    }
    if (grid < 0) return;
    if (hipMemsetAsync((char*)d_ws + WS_CTL, 0, CTL_ZERO_BYTES, stream) != hipSuccess) { fprintf(stderr, "kernel_launch: memset failed\n"); return; }
    Args a{};
    for (int i = 0; i < 20; ++i) a.in[i] = d_in[i];
    a.out = (float*)d_out; a.ws = (unsigned char*)d_ws; a.pad = 0;
#if MK_ONE_LAUNCH
    a.ph_lo = 0; a.ph_hi = NPH; a.li = 0;
    hipLaunchKernelGGL(fwd, dim3(grid), dim3(NTHREADS), LDS_BYTES, stream, a);
#else
    for (int p = 0; p < NPH; ++p) { a.ph_lo = p; a.ph_hi = p + 1; a.li = 0; hipLaunchKernelGGL(fwd, dim3(grid), dim3(NTHREADS), LDS_BYTES, stream, a); }
#endif
    const hipError_t le = hipPeekAtLastError();
    if (le != hipSuccess) fprintf(stderr, "kernel_launch: launch failed: %s\n", hipGetErrorName(le));
}
```
